# Optimizing an MI355X kernel written in HIP

```python
import math
import jax, jax.numpy as jnp
from jax import lax
import numpy as np

D_MODEL = 1024
BATCH = 2
SEQ = 16384
DEPTH = 4

N_MIXERS = 2
N_NSA_LAYERS = (DEPTH + 1) // 2
N_S5_LAYERS = DEPTH // 2

N_HEADS = 16
HEAD_DIM = D_MODEL // N_HEADS
N_KV_GROUPS = 4
HEADS_PER_GROUP = N_HEADS // N_KV_GROUPS
KV_DIM = N_KV_GROUPS * HEAD_DIM
CMP_BLOCK = 32
CMP_STRIDE = 16
CMP_HIDDEN = 256
SEL_BLOCK = 64
SEL_TOPN = 16
WINDOW = 512
Q_BLOCK = 128
N_BRANCHES = 3
PROJ_COLS = D_MODEL + 6 * KV_DIM + N_HEADS * N_BRANCHES

S5_GROUP = 16
S5_GROUPS = D_MODEL // S5_GROUP
S5_STATE = 64

FFN_HIDDEN = ((8 * D_MODEL + 3 * 256 - 1) // (3 * 256)) * 256

EPS = 1e-6
NEG = -1e30
FORCE = 1e4

kernel_name = "hybrid_nsa_s5_interleaved_trunk"


def rmsnorm(x, g):
    xf = x.astype(jnp.float32)
    var = jnp.mean(xf * xf, axis=-1, keepdims=True)
    return xf * lax.rsqrt(var + EPS) * g.astype(jnp.float32)


def masked_softmax(s, mask):
    s = jnp.where(mask, s.astype(jnp.float32), NEG)
    return jax.nn.softmax(s, axis=-1) * mask


def compress_tokens(kv, pos, w1, b1, w2, b2):
    b, t = kv.shape[0], kv.shape[1]
    n_cmp = (t - CMP_BLOCK) // CMP_STRIDE + 1
    idx = jnp.arange(n_cmp)[:, None] * CMP_STRIDE + jnp.arange(CMP_BLOCK)[None, :]
    blocks = kv[:, idx] + pos[:, None, :]
    blocks = blocks.transpose(0, 1, 3, 2, 4).reshape(b, n_cmp, N_KV_GROUPS, CMP_BLOCK * HEAD_DIM)
    hid = jax.nn.gelu(blocks @ w1 + b1)
    return hid @ w2 + b2


def nsa_mixer(h, w_in, w_out, q_gain, k_gain, cmp_pos, cmp_w1, cmp_b1, cmp_w2, cmp_b2):
    b, t, _ = h.shape
    G, R, dh = N_KV_GROUPS, HEADS_PER_GROUP, HEAD_DIM
    scale = 1.0 / math.sqrt(dh)
    proj = h @ w_in
    cuts = [D_MODEL + i * KV_DIM for i in range(7)]
    q, kc_raw, vc_raw, ks_raw, vs_raw, kw_raw, vw_raw, g = jnp.split(proj, cuts, axis=-1)
    q = rmsnorm(q.reshape(b, t, N_HEADS, dh), q_gain)
    kvs = lambda a: a.reshape(b, t, G, dh)
    kc = rmsnorm(compress_tokens(kvs(kc_raw), cmp_pos[0], cmp_w1[0], cmp_b1[0], cmp_w2[0], cmp_b2[0]), k_gain[0])
    vc = compress_tokens(kvs(vc_raw), cmp_pos[1], cmp_w1[1], cmp_b1[1], cmp_w2[1], cmp_b2[1])
    ks = rmsnorm(kvs(ks_raw), k_gain[1])
    vs = kvs(vs_raw)
    kw = rmsnorm(kvs(kw_raw), k_gain[2])
    vw = kvs(vw_raw)
    gates = jax.nn.sigmoid(g.astype(jnp.float32))

    n_cmp = kc.shape[1]
    n_sblk = t // SEL_BLOCK
    top_n = min(SEL_TOPN, n_sblk)
    cmp_start = jnp.arange(n_cmp) * CMP_STRIDE
    cmp_end = cmp_start + CMP_BLOCK - 1
    sblk = jnp.arange(n_sblk)
    overlap = ((cmp_start[:, None] < (sblk[None, :] + 1) * SEL_BLOCK)
               & (cmp_start[:, None] + CMP_BLOCK > sblk[None, :] * SEL_BLOCK)).astype(jnp.float32)
    ks_blocks = ks.reshape(b, n_sblk, SEL_BLOCK, G, dh).transpose(0, 3, 1, 2, 4)
    vs_blocks = vs.reshape(b, n_sblk, SEL_BLOCK, G, dh).transpose(0, 3, 1, 2, 4)
    pad = ((0, 0), (WINDOW, 0), (0, 0), (0, 0))
    kw_pad = jnp.pad(kw, pad)
    vw_pad = jnp.pad(vw, pad)
    b_idx = jnp.arange(b)[:, None, None, None]
    g_idx = jnp.arange(G)[None, :, None, None]

    def block_fn(args):
        j, qb, gb = args
        tq = j * Q_BLOCK + jnp.arange(Q_BLOCK)
        s = jnp.einsum('bqgrd,bngd->bgrqn', qb, kc).astype(jnp.float32) * scale
        p_cmp = masked_softmax(s, cmp_end[None, :] <= tq[:, None])
        o_cmp = jnp.einsum('bgrqn,bngd->bqgrd', p_cmp, vc)
        p_sel = jnp.einsum('bgqn,ns->bgqs', p_cmp.sum(axis=2), overlap)
        cur = tq // SEL_BLOCK
        valid = sblk[None, :] * SEL_BLOCK <= tq[:, None]
        forced = (sblk[None, :] == 0) | (sblk[None, :] == cur[:, None]) | (sblk[None, :] == cur[:, None] - 1)
        score = jnp.where(forced, FORCE, jnp.where(valid, p_sel, NEG))
        vals, idx = lax.top_k(score, top_n)
        sel_ok = vals > 0.5 * NEG
        k_g = ks_blocks[b_idx, g_idx, idx].reshape(b, G, Q_BLOCK, top_n * SEL_BLOCK, dh)
        v_g = vs_blocks[b_idx, g_idx, idx].reshape(b, G, Q_BLOCK, top_n * SEL_BLOCK, dh)
        kpos = (idx[..., None] * SEL_BLOCK + jnp.arange(SEL_BLOCK)).reshape(b, G, Q_BLOCK, top_n * SEL_BLOCK)
        ok = jnp.repeat(sel_ok, SEL_BLOCK, axis=-1) & (kpos <= tq[:, None])
        s = jnp.einsum('bqgrd,bgqkd->bgrqk', qb, k_g).astype(jnp.float32) * scale
        p = masked_softmax(s, ok[:, :, None])
        o_sel = jnp.einsum('bgrqk,bgqkd->bqgrd', p, v_g)
        kb = lax.dynamic_slice_in_dim(kw_pad, j * Q_BLOCK, Q_BLOCK + WINDOW, axis=1)
        vb = lax.dynamic_slice_in_dim(vw_pad, j * Q_BLOCK, Q_BLOCK + WINDOW, axis=1)
        wpos = j * Q_BLOCK - WINDOW + jnp.arange(Q_BLOCK + WINDOW)
        m = (wpos[None, :] >= 0) & (wpos[None, :] <= tq[:, None]) & (tq[:, None] - wpos[None, :] < WINDOW)
        s = jnp.einsum('bqgrd,bkgd->bgrqk', qb, kb).astype(jnp.float32) * scale
        p = masked_softmax(s, m)
        o_win = jnp.einsum('bgrqk,bkgd->bqgrd', p, vb)
        o = gb[..., 0:1] * o_cmp + gb[..., 1:2] * o_sel + gb[..., 2:3] * o_win
        return o.reshape(b, Q_BLOCK, D_MODEL)

    nqb = t // Q_BLOCK
    q_blocks = q.reshape(b, nqb, Q_BLOCK, G, R, dh).transpose(1, 0, 2, 3, 4, 5)
    g_blocks = gates.reshape(b, nqb, Q_BLOCK, G, R, N_BRANCHES).transpose(1, 0, 2, 3, 4, 5)
    o = lax.map(block_fn, (jnp.arange(nqb), q_blocks, g_blocks))
    o = o.transpose(1, 0, 2, 3).reshape(b, t, D_MODEL)
    return o @ w_out


def complex_affine_combine(e1, e2):
    a1r, a1i, b1r, b1i = e1
    a2r, a2i, b2r, b2i = e2
    ar = a2r * a1r - a2i * a1i
    ai = a2r * a1i + a2i * a1r
    br = a2r * b1r - a2i * b1i + b2r
    bi = a2r * b1i + a2i * b1r + b2i
    return (ar, ai, br, bi)


def s5_mixer(h, w_in, b_re, b_im, c_re, c_im, d_skip, log_dt, a_re, a_im, w_glu):
    b, t, _ = h.shape
    f32 = jnp.float32
    u = (h @ w_in).astype(f32).reshape(b, t, S5_GROUPS, S5_GROUP)
    dt = jnp.exp(log_dt.astype(f32))[:, None]
    ar, ai = a_re.astype(f32), a_im.astype(f32)
    mag = jnp.exp(dt * ar)
    abar_r = mag * jnp.cos(dt * ai)
    abar_i = mag * jnp.sin(dt * ai)
    den = ar * ar + ai * ai
    coef_r = ((abar_r - 1.0) * ar + abar_i * ai) / den
    coef_i = (abar_i * ar - (abar_r - 1.0) * ai) / den
    br, bi = b_re.astype(f32), b_im.astype(f32)
    bbar_r = coef_r[..., None] * br - coef_i[..., None] * bi
    bbar_i = coef_r[..., None] * bi + coef_i[..., None] * br
    bu_r = jnp.einsum('btgc,gpc->btgp', u, bbar_r)
    bu_i = jnp.einsum('btgc,gpc->btgp', u, bbar_i)
    a_full_r = jnp.broadcast_to(abar_r, bu_r.shape)
    a_full_i = jnp.broadcast_to(abar_i, bu_r.shape)
    _, _, x_r, x_i = lax.associative_scan(complex_affine_combine, (a_full_r, a_full_i, bu_r, bu_i), axis=1)
    y = (jnp.einsum('btgp,gcp->btgc', x_r, c_re) - jnp.einsum('btgp,gcp->btgc', x_i, c_im)
         + d_skip.reshape(S5_GROUPS, S5_GROUP) * u)
    z = jax.nn.gelu(y.reshape(b, t, D_MODEL))
    vg = z @ w_glu
    return vg[..., :D_MODEL] * jax.nn.sigmoid(vg[..., D_MODEL:])


def swiglu(h, w_gate, w_up, w_down):
    return (jax.nn.silu(h @ w_gate) * (h @ w_up)) @ w_down


def setup_inputs(seed: int = 0) -> dict:
    key = jax.random.key(seed)
    ks = jax.random.split(key, 32)
    nrm = lambda k, s: jax.random.normal(k, s, jnp.float32)
    L, Ln, Ls = DEPTH, N_NSA_LAYERS, N_S5_LAYERS
    D, G, P, C = D_MODEL, S5_GROUPS, S5_STATE, S5_GROUP
    flat = CMP_BLOCK * HEAD_DIM
    return {
        "x": nrm(ks[0], (BATCH, SEQ, D)),
        "mix_norm": 1.0 + 0.01 * nrm(ks[1], (L, D)),
        "ffn_norm": 1.0 + 0.01 * nrm(ks[2], (L, D)),
        "nsa_w_in": nrm(ks[3], (Ln, D, PROJ_COLS)) * D ** -0.5,
        "nsa_w_out": nrm(ks[4], (Ln, D, D)) * D ** -0.5,
        "nsa_q_gain": 1.0 + 0.01 * nrm(ks[5], (Ln, HEAD_DIM)),
        "nsa_k_gain": 1.0 + 0.01 * nrm(ks[6], (Ln, N_BRANCHES, HEAD_DIM)),
        "nsa_cmp_pos": 0.1 * nrm(ks[7], (Ln, 2, CMP_BLOCK, HEAD_DIM)),
        "nsa_cmp_w1": nrm(ks[8], (Ln, 2, flat, CMP_HIDDEN)) * flat ** -0.5,
        "nsa_cmp_b1": 0.01 * nrm(ks[9], (Ln, 2, CMP_HIDDEN)),
        "nsa_cmp_w2": nrm(ks[10], (Ln, 2, CMP_HIDDEN, HEAD_DIM)) * CMP_HIDDEN ** -0.5,
        "nsa_cmp_b2": 0.01 * nrm(ks[11], (Ln, 2, HEAD_DIM)),
        "s5_w_in": nrm(ks[12], (Ls, D, D)) * D ** -0.5,
        "s5_b_re": nrm(ks[13], (Ls, G, P, C)) * (2 * C) ** -0.5,
        "s5_b_im": nrm(ks[14], (Ls, G, P, C)) * (2 * C) ** -0.5,
        "s5_c_re": nrm(ks[15], (Ls, G, C, P)) * (2 * P) ** -0.5,
        "s5_c_im": nrm(ks[16], (Ls, G, C, P)) * (2 * P) ** -0.5,
        "s5_d": nrm(ks[17], (Ls, D)),
        "s5_log_dt": jax.random.uniform(ks[18], (Ls, G), jnp.float32, math.log(0.001), math.log(0.1)),
        "s5_a_re": -0.5 + 0.01 * nrm(ks[19], (Ls, G, P)),
        "s5_a_im": math.pi * jnp.arange(P, dtype=jnp.float32) + 0.01 * nrm(ks[20], (Ls, G, P)),
        "s5_w_glu": nrm(ks[21], (Ls, D, 2 * D)) * D ** -0.5,
        "ffn_w_gate": nrm(ks[22], (L, D, FFN_HIDDEN)) * D ** -0.5,
        "ffn_w_up": nrm(ks[23], (L, D, FFN_HIDDEN)) * D ** -0.5,
        "ffn_w_down": nrm(ks[24], (L, FFN_HIDDEN, D)) * FFN_HIDDEN ** -0.5,
    }


def reference(x, mix_norm, ffn_norm, nsa_w_in, nsa_w_out, nsa_q_gain, nsa_k_gain, nsa_cmp_pos,
              nsa_cmp_w1, nsa_cmp_b1, nsa_cmp_w2, nsa_cmp_b2, s5_w_in, s5_b_re, s5_b_im, s5_c_re,
              s5_c_im, s5_d, s5_log_dt, s5_a_re, s5_a_im, s5_w_glu, ffn_w_gate, ffn_w_up, ffn_w_down):
    for layer in range(DEPTH):
        h = rmsnorm(x, mix_norm[layer])
        i = layer // N_MIXERS
        if layer % N_MIXERS == 0:
            mix = nsa_mixer(h, nsa_w_in[i], nsa_w_out[i], nsa_q_gain[i], nsa_k_gain[i], nsa_cmp_pos[i],
                            nsa_cmp_w1[i], nsa_cmp_b1[i], nsa_cmp_w2[i], nsa_cmp_b2[i])
        else:
            mix = s5_mixer(h, s5_w_in[i], s5_b_re[i], s5_b_im[i], s5_c_re[i], s5_c_im[i], s5_d[i],
                           s5_log_dt[i], s5_a_re[i], s5_a_im[i], s5_w_glu[i])
        x = x + mix.astype(x.dtype)
        h = rmsnorm(x, ffn_norm[layer])
        x = x + swiglu(h, ffn_w_gate[layer], ffn_w_up[layer], ffn_w_down[layer]).astype(x.dtype)
    return x
```

```cpp
#include <hip/hip_runtime.h>
#include <hip/hip_cooperative_groups.h>
#include <cstdio>
#include <cstdint>
namespace cg = cooperative_groups;

namespace pg8 {
#define PG8_LAS __attribute__((address_space(3)))
typedef unsigned short bf16_t;
typedef short bf16x8 __attribute__((ext_vector_type(8)));
typedef float f32x4 __attribute__((ext_vector_type(4)));
typedef unsigned u32x4 __attribute__((ext_vector_type(4)));
constexpr int BM = 256, BK = 64, HALF = 128, HTB = HALF * BK * 2  , STAGE_BYTES = 8 * HTB, NXCD = 8, WGM = 8;

__host__ __device__ __forceinline__ int lds_byte(int r, int c) { const int st = (r >> 4) * 2 + (c >> 5), rr = r & 15, cc = c & 31, ob = rr * 64 + cc * 2; return st * 1024 + (ob ^ (((ob >> 9) & 1) << 5)); }
__host__ __device__ __forceinline__ void stage_rc(int b, int& R, int& C) { const int st = b / 1024, sb = b % 1024, swz = sb ^ (((sb >> 9) & 1) << 5); R = (st >> 1) * 16 + swz / 64; C = (st & 1) * 32 + (swz % 64) / 2; }
__host__ __device__ __forceinline__ int perm32(int rho) { const int n = rho >> 4, i = rho & 15; return 8 * (i >> 2) + 4 * n + (i & 3); }

struct Unit { int pm, pn; };
struct Gemm { const bf16_t* A; const bf16_t* Bt; int M, N, K, lda; };

struct StaticOrder {
    int nM, nN, nwg, G, c;
    __host__ __device__ void init(int M, int N, int G_, int c_) { nM = M / BM; nN = N / BM; nwg = nM * nN; G = G_; c = c_; }
    __host__ __device__ bool next(int i, Unit& u) const {
        const long L = (long)i * G + c; if (L >= nwg) return false;
        int wgid = (int)L; { const int q = nwg / NXCD, r = nwg % NXCD, xcd = wgid % NXCD, off = wgid / NXCD; wgid = (xcd < r ? xcd * (q + 1) : r * (q + 1) + (xcd - r) * q) + off; }
        const int nig = WGM * nN, gid = wgid / nig, fm = gid * WGM, gsz = (nM - fm) < WGM ? (nM - fm) : WGM;
        u.pm = fm + ((wgid % nig) % gsz); u.pn = (wgid % nig) / gsz; return true;
    }
    __device__ __forceinline__ void a_ready(const Unit&) const {}
    __device__ __forceinline__ void done(const Unit&) const {}
};


typedef unsigned u32x2 __attribute__((ext_vector_type(2)));
__device__ __forceinline__ unsigned cvt_pk_bf16(float lo, float hi) { unsigned r; asm("v_cvt_pk_bf16_f32 %0, %1, %2" : "=v"(r) : "v"(lo), "v"(hi)); return r; }
__device__ __forceinline__ float fast_sigmoid(float x) { return __builtin_amdgcn_rcpf(1.0f + __expf(-x)); }
__device__ __forceinline__ float gelu_tanh(float x) { const float u = 1.5957691216f * (x + 0.044715f * x * x * x); return x * __builtin_amdgcn_rcpf(1.0f + __expf(-u)); }
enum { EPI_PROJ = 0, EPI_CMP1 = 1, EPI_RESID = 2, EPI_SWIGLU = 3, EPI_PLAIN = 4, EPI_GLU = 5 };
struct Epi {
    static constexpr bool PERM = false, AFTER_DRAIN = false;
    int mode; int ldo;
    const float* xsrc; float* xdst;
    bf16_t* o0;
    bf16_t* kv; size_t kvstride;
    float* gates;
    const float* bias;
    const unsigned long long* ss_in;
    unsigned long long* ss_out; bf16_t* xn_out;
    __device__ __forceinline__ float rowscale(int row) const { return ss_in ? 1.0f / sqrtf((float)ss_in[row] * (1.0f / (1024.0f * 16777216.0f)) + 1e-6f) : 1.0f; }
    __device__ __forceinline__ void operator()(const f32x4 (&acc)[2][2][4][2], const Unit& u, int wr, int wc, int fr, int fq) const {
        const int row0 = u.pm * BM + wr * 64 + fr;
        const int colw = wc * 32 + fq * 4;
        if (mode == EPI_PROJ) {
            if (u.pn < 4) {
#pragma unroll
                for (int ai = 0; ai < 2; ++ai)
#pragma unroll
                    for (int m = 0; m < 4; ++m) { bf16_t* rp = o0 + (size_t)(row0 + ai * HALF + m * 16) * 1024 + u.pn * 256 + colw; const float rs = rowscale(row0 + ai * HALF + m * 16);
#pragma unroll
                        for (int bj = 0; bj < 2; ++bj)
#pragma unroll
                            for (int n = 0; n < 2; ++n) { const f32x4 v = acc[ai][bj][m][n] * rs; u32x2 w; w.x = cvt_pk_bf16(v[0], v[1]); w.y = cvt_pk_bf16(v[2], v[3]); *(u32x2*)(rp + bj * HALF + n * 16) = w; } }
            } else if (u.pn < 10) {
                bf16_t* base = kv + (size_t)(u.pn - 4) * kvstride;
#pragma unroll
                for (int ai = 0; ai < 2; ++ai)
#pragma unroll
                    for (int m = 0; m < 4; ++m) { const int row = row0 + ai * HALF + m * 16; const int b = row >> 14, t = row & 16383; const float rs = rowscale(row);
#pragma unroll
                        for (int bj = 0; bj < 2; ++bj)
#pragma unroll
                            for (int n = 0; n < 2; ++n) { const int col = bj * HALF + n * 16 + colw; const int g = col >> 6, d = col & 63;
                                const f32x4 v = acc[ai][bj][m][n] * rs; u32x2 w; w.x = cvt_pk_bf16(v[0], v[1]); w.y = cvt_pk_bf16(v[2], v[3]);
                                *(u32x2*)(base + ((size_t)((b * 4 + g) * 16384 + t)) * 64 + d) = w; } }
            } else {
#pragma unroll
                for (int ai = 0; ai < 2; ++ai)
#pragma unroll
                    for (int m = 0; m < 4; ++m) { const int row = row0 + ai * HALF + m * 16; const float rs = rowscale(row);
#pragma unroll
                        for (int n = 0; n < 2; ++n) { const int col = n * 16 + colw;
                            if (col < 48) { const f32x4 v = acc[ai][0][m][n] * rs; f32x4 o; o[0] = fast_sigmoid(v[0]); o[1] = fast_sigmoid(v[1]); o[2] = fast_sigmoid(v[2]); o[3] = fast_sigmoid(v[3]);
                                *(f32x4*)(gates + (size_t)row * 48 + col) = o; } } }
            }
        } else if (mode == EPI_CMP1 || mode == EPI_PLAIN) {
#pragma unroll
            for (int bj = 0; bj < 2; ++bj)
#pragma unroll
                for (int n = 0; n < 2; ++n) { const int col = u.pn * BM + bj * HALF + n * 16 + colw;
                    f32x4 bv = (f32x4){0.f, 0.f, 0.f, 0.f}; if (mode == EPI_CMP1) bv = *(const f32x4*)(bias + col);
#pragma unroll
                    for (int ai = 0; ai < 2; ++ai)
#pragma unroll
                        for (int m = 0; m < 4; ++m) { f32x4 v = acc[ai][bj][m][n] * rowscale(row0 + ai * HALF + m * 16) + bv;
                            if (mode == EPI_CMP1) { v[0] = gelu_tanh(v[0]); v[1] = gelu_tanh(v[1]); v[2] = gelu_tanh(v[2]); v[3] = gelu_tanh(v[3]); }
                            u32x2 w; w.x = cvt_pk_bf16(v[0], v[1]); w.y = cvt_pk_bf16(v[2], v[3]);
                            *(u32x2*)(o0 + (size_t)(row0 + ai * HALF + m * 16) * ldo + col) = w; } }
        } else if (mode == EPI_RESID) {
#pragma unroll
            for (int ai = 0; ai < 2; ++ai)
#pragma unroll
                for (int m = 0; m < 4; ++m) { const size_t off = (size_t)(row0 + ai * HALF + m * 16) * 1024 + u.pn * BM + colw; float sq = 0.f;
#pragma unroll
                    for (int bj = 0; bj < 2; ++bj)
#pragma unroll
                        for (int n = 0; n < 2; ++n) { const u32x2 xb = *(const u32x2*)(xn_out + off + bj * HALF + n * 16); const f32x4 bs = (f32x4){__uint_as_float(xb.x << 16), __uint_as_float(xb.x & 0xffff0000u), __uint_as_float(xb.y << 16), __uint_as_float(xb.y & 0xffff0000u)};
                            const f32x4 o = bs + acc[ai][bj][m][n]; if (xdst) *(f32x4*)(xdst + off + bj * HALF + n * 16) = o;
                            if (ss_out) { u32x2 w; w.x = cvt_pk_bf16(o[0], o[1]); w.y = cvt_pk_bf16(o[2], o[3]); *(u32x2*)(xn_out + off + bj * HALF + n * 16) = w; sq += (o[0] * o[0] + o[1] * o[1]) + (o[2] * o[2] + o[3] * o[3]); } }
                    if (ss_out) { sq += __shfl_xor(sq, 16); sq += __shfl_xor(sq, 32); if (fq == 0) atomicAdd(ss_out + row0 + ai * HALF + m * 16, (unsigned long long)(sq * 16777216.0f)); } }
        } else if (mode == EPI_SWIGLU) {
#pragma unroll
            for (int ai = 0; ai < 2; ++ai)
#pragma unroll
                for (int m = 0; m < 4; ++m) { bf16_t* rp = o0 + (size_t)(row0 + ai * HALF + m * 16) * ldo + u.pn * HALF + colw; const float rs = rowscale(row0 + ai * HALF + m * 16);
#pragma unroll
                    for (int n = 0; n < 2; ++n) { const f32x4 a = acc[ai][0][m][n] * rs, b = acc[ai][1][m][n] * rs; f32x4 h;
#pragma unroll
                        for (int e = 0; e < 4; ++e) h[e] = a[e] * fast_sigmoid(a[e]) * b[e];
                        u32x2 w; w.x = cvt_pk_bf16(h[0], h[1]); w.y = cvt_pk_bf16(h[2], h[3]); *(u32x2*)(rp + n * 16) = w; } }
        } else {
#pragma unroll
            for (int ai = 0; ai < 2; ++ai)
#pragma unroll
                for (int m = 0; m < 4; ++m) { const size_t off = (size_t)(row0 + ai * HALF + m * 16) * 1024 + u.pn * HALF + colw; float sq = 0.f;
#pragma unroll
                    for (int n = 0; n < 2; ++n) { const f32x4 a = acc[ai][0][m][n], b = acc[ai][1][m][n]; const u32x2 xb = *(const u32x2*)(xn_out + off + n * 16);
                        f32x4 o = (f32x4){__uint_as_float(xb.x << 16), __uint_as_float(xb.x & 0xffff0000u), __uint_as_float(xb.y << 16), __uint_as_float(xb.y & 0xffff0000u)};
#pragma unroll
                        for (int e = 0; e < 4; ++e) o[e] += a[e] * fast_sigmoid(b[e]);
                        if (ss_out) { u32x2 w; w.x = cvt_pk_bf16(o[0], o[1]); w.y = cvt_pk_bf16(o[2], o[3]); *(u32x2*)(xn_out + off + n * 16) = w; sq += (o[0] * o[0] + o[1] * o[1]) + (o[2] * o[2] + o[3] * o[3]); } }
                    if (ss_out) { sq += __shfl_xor(sq, 16); sq += __shfl_xor(sq, 32); if (fq == 0) atomicAdd(ss_out + row0 + ai * HALF + m * 16, (unsigned long long)(sq * 16777216.0f)); } }
        }
    }
};

template <class Epi, class Sched, bool ALIGN_EPI = false, bool SP2 = false>
__device__ __forceinline__ void gemm_phase(PG8_LAS unsigned char* lds, const Gemm g, const Sched& S, const Epi& E) {
    int tid_ = threadIdx.x; asm volatile("" : "+v"(tid_)); const int tid = tid_, wid = __builtin_amdgcn_readfirstlane(tid >> 6), lane = tid & 63, wr = wid >> 2, wc = wid & 3, fr = lane & 15, fq = lane >> 4;
    const int K = g.K, nt = K / BK;
    unsigned voffA[2], voffB[2];
#pragma unroll
    for (int i = 0; i < 2; ++i) { int R, C; stage_rc(tid * 16 + i * 8192, R, C); const int Rb = Epi::PERM ? ((R & ~31) + perm32(R & 31)) : R;
        voffA[i] = (unsigned)(R * g.lda + C) * 2u; voffB[i] = (unsigned)(Rb * K + C) * 2u; }
    const size_t kstep = (size_t)(BK * 2);
    const size_t hstep = (size_t)HALF * K * 2;
    const size_t tstep = 2 * hstep; const size_t hstepA = (size_t)HALF * g.lda * 2, tstepA = 2 * hstepA;
    const unsigned ldsw = (unsigned)wid * 1024u;
    const int aoff = lds_byte(wr * 64 + fr, fq * 8), boff = lds_byte(wc * 32 + fr, fq * 8);
#define PG8_SA(b, h) (((b) * 2 + (h)) * HTB)
#define PG8_SB(b, h) ((4 + (b) * 2 + (h)) * HTB)
#define PG8_STAGE(bufoff, gbase, voff) do { _Pragma("unroll") for (int _i = 0; _i < 2; ++_i) \
        __builtin_amdgcn_global_load_lds((const unsigned*)((const char*)(gbase) + (voff)[_i]), (PG8_LAS unsigned*)(lds + (bufoff) + ldsw + _i * 8192), 16, 0, 0); } while (0)
#define PG8_LDA(dst, b, h) do { _Pragma("unroll") for (int m = 0; m < 4; ++m) _Pragma("unroll") for (int k = 0; k < 2; ++k) dst[m][k] = *(const PG8_LAS bf16x8*)(lds + PG8_SA(b, h) + aoff + m * 2048 + k * 1024); } while (0)
#define PG8_LDB(dst, b, h) do { _Pragma("unroll") for (int n = 0; n < 2; ++n) _Pragma("unroll") for (int k = 0; k < 2; ++k) dst[n][k] = *(const PG8_LAS bf16x8*)(lds + PG8_SB(b, h) + boff + n * 2048 + k * 1024); } while (0)
#define PG8_MMA(ai, bj, At, Bt) do { __builtin_amdgcn_s_setprio(1); _Pragma("unroll") for (int m = 0; m < 4; ++m) _Pragma("unroll") for (int n = 0; n < 2; ++n) _Pragma("unroll") for (int k = 0; k < 2; ++k) \
        acc[ai][bj][m][n] = __builtin_amdgcn_mfma_f32_16x16x32_bf16(Bt[n][k], At[m][k], acc[ai][bj][m][n], 0, 0, 0); __builtin_amdgcn_s_setprio(0); } while (0)
#define PG8_WAIT_V(n) asm volatile("s_waitcnt vmcnt(" #n ")" ::: "memory")
#define PG8_WAIT_L(n) asm volatile("s_waitcnt lgkmcnt(" #n ")" ::: "memory")
#define PG8_BAR __builtin_amdgcn_s_barrier()
#define PG8_SCHED __builtin_amdgcn_sched_barrier(0)
    Unit cur, nxt; int ui = 0;
    if (!S.next(0, cur)) return;
    f32x4 acc[2][2][4][2];
#pragma unroll
    for (int a = 0; a < 2; ++a)
#pragma unroll
        for (int b = 0; b < 2; ++b)
#pragma unroll
            for (int m = 0; m < 4; ++m)
#pragma unroll
                for (int n = 0; n < 2; ++n) acc[a][b][m][n] = (f32x4){0.f, 0.f, 0.f, 0.f};
    bf16x8 At[4][2], B0[2][2], B1[2][2];
    const char* cA = (const char*)g.A + (size_t)cur.pm * tstepA; const char* cB = (const char*)g.Bt + (size_t)cur.pn * tstep;
    S.a_ready(cur);
    if constexpr (SP2) {
        PG8_STAGE(PG8_SB(0, 0), cB, voffB); PG8_STAGE(PG8_SB(0, 1), cB + hstep, voffB); PG8_STAGE(PG8_SA(0, 0), cA, voffA); PG8_STAGE(PG8_SA(0, 1), cA + hstepA, voffA);
        if (wr == 1) PG8_BAR;
        PG8_WAIT_V(2); PG8_BAR;
        PG8_STAGE(PG8_SB(1, 0), cB + kstep, voffB); PG8_STAGE(PG8_SA(1, 0), cA + kstep, voffA); PG8_STAGE(PG8_SB(1, 1), cB + hstep + kstep, voffB);
        PG8_WAIT_V(6); PG8_BAR;
    } else {
        PG8_STAGE(PG8_SB(0, 0), cB, voffB); PG8_STAGE(PG8_SA(0, 0), cA, voffA); PG8_STAGE(PG8_SB(0, 1), cB + hstep, voffB); PG8_STAGE(PG8_SA(0, 1), cA + hstepA, voffA);
        if (wr == 1) PG8_BAR;
        PG8_WAIT_V(4); PG8_BAR;
        PG8_STAGE(PG8_SB(1, 0), cB + kstep, voffB); PG8_STAGE(PG8_SA(1, 0), cA + kstep, voffA); PG8_STAGE(PG8_SB(1, 1), cB + hstep + kstep, voffB);
        PG8_WAIT_V(6); PG8_BAR;
    }
    for (;;) {
        const bool has_next = S.next(ui + 1, nxt);
        const char* nA = has_next ? (const char*)g.A + (size_t)nxt.pm * tstepA : cA; const char* nB = has_next ? (const char*)g.Bt + (size_t)nxt.pn * tstep : cB;
        for (int t = 0; t < nt; t += 2) {
            const bool last = (t == nt - 2);
            const char* a1 = cA + (size_t)(t + 1) * kstep;
            const char* a2 = last ? nA : cA + (size_t)(t + 2) * kstep; const char* b2 = last ? nB : cB + (size_t)(t + 2) * kstep;
            const char* a3 = a2 + kstep; const char* b3 = b2 + kstep;
            if (last && has_next) S.a_ready(nxt);
            if constexpr (SP2) {
            PG8_LDB(B0, 0, 0); PG8_LDB(B1, 0, 1); PG8_SCHED; PG8_LDA(At, 0, 0); PG8_STAGE(PG8_SA(1, 1), a1 + hstepA, voffA);
            PG8_WAIT_V(8); PG8_WAIT_L(0); PG8_BAR; PG8_MMA(0, 0, At, B0); PG8_MMA(0, 1, At, B1); PG8_BAR; PG8_SCHED;
            PG8_LDA(At, 0, 1); PG8_STAGE(PG8_SB(0, 0), b2, voffB); PG8_STAGE(PG8_SB(0, 1), b2 + hstep, voffB); PG8_STAGE(PG8_SA(0, 0), a2, voffA);
            PG8_WAIT_V(8); PG8_WAIT_L(0); PG8_BAR; PG8_MMA(1, 0, At, B0); PG8_MMA(1, 1, At, B1); PG8_BAR; PG8_SCHED;
            PG8_LDB(B0, 1, 0); PG8_LDB(B1, 1, 1); PG8_SCHED; PG8_LDA(At, 1, 0); PG8_STAGE(PG8_SA(0, 1), a2 + hstepA, voffA);
            PG8_WAIT_V(8); PG8_WAIT_L(0); PG8_BAR; PG8_MMA(0, 0, At, B0); PG8_MMA(0, 1, At, B1); PG8_BAR; PG8_SCHED;
            PG8_LDA(At, 1, 1); PG8_STAGE(PG8_SB(1, 0), b3, voffB); PG8_STAGE(PG8_SB(1, 1), b3 + hstep, voffB); PG8_STAGE(PG8_SA(1, 0), a3, voffA);
            PG8_WAIT_V(8); PG8_WAIT_L(0); PG8_BAR; PG8_MMA(1, 0, At, B0); PG8_MMA(1, 1, At, B1); PG8_BAR; PG8_SCHED;
            } else {
            PG8_LDB(B0, 0, 0); PG8_SCHED; PG8_LDA(At, 0, 0); PG8_STAGE(PG8_SA(1, 1), a1 + hstepA, voffA);
            PG8_WAIT_L(8); PG8_BAR; PG8_WAIT_L(0); PG8_MMA(0, 0, At, B0); PG8_BAR; PG8_SCHED;
            PG8_LDB(B1, 0, 1); PG8_STAGE(PG8_SB(0, 0), b2, voffB);
            PG8_BAR; PG8_WAIT_L(0); PG8_MMA(0, 1, At, B1); PG8_BAR;
            PG8_LDA(At, 0, 1); PG8_STAGE(PG8_SA(0, 0), a2, voffA);
            PG8_BAR; PG8_WAIT_L(0); PG8_MMA(1, 0, At, B0); PG8_BAR; PG8_SCHED;
            PG8_STAGE(PG8_SB(0, 1), b2 + hstep, voffB);
            PG8_WAIT_V(6); PG8_BAR; PG8_MMA(1, 1, At, B1); PG8_BAR;
            PG8_LDB(B0, 1, 0); PG8_SCHED; PG8_LDA(At, 1, 0); PG8_STAGE(PG8_SA(0, 1), a2 + hstepA, voffA);
            PG8_WAIT_L(8); PG8_BAR; PG8_WAIT_L(0); PG8_MMA(0, 0, At, B0); PG8_BAR; PG8_SCHED;
            PG8_LDB(B1, 1, 1); PG8_STAGE(PG8_SB(1, 0), b3, voffB);
            PG8_BAR; PG8_WAIT_L(0); PG8_MMA(0, 1, At, B1); PG8_BAR;
            PG8_LDA(At, 1, 1); PG8_STAGE(PG8_SA(1, 0), a3, voffA);
            PG8_BAR; PG8_WAIT_L(0); PG8_MMA(1, 0, At, B0); PG8_BAR; PG8_SCHED;
            PG8_STAGE(PG8_SB(1, 1), b3 + hstep, voffB);
            PG8_WAIT_V(6); PG8_BAR; PG8_MMA(1, 1, At, B1); PG8_BAR;
            }
        }
        if constexpr (ALIGN_EPI) { if (wr == 0) PG8_BAR; }
        if constexpr (!Epi::AFTER_DRAIN) { E(acc, cur, wr, wc, fr, fq); S.done(cur); }
        if (!has_next) break;
#pragma unroll
        for (int a = 0; a < 2; ++a)
#pragma unroll
            for (int b = 0; b < 2; ++b)
#pragma unroll
                for (int m = 0; m < 4; ++m)
#pragma unroll
                    for (int n = 0; n < 2; ++n) acc[a][b][m][n] = (f32x4){0.f, 0.f, 0.f, 0.f};
        cur = nxt; cA = nA; cB = nB; ++ui;
        if constexpr (ALIGN_EPI) { if (wr == 1) PG8_BAR; }
    }
    PG8_WAIT_V(0);
    if constexpr (!ALIGN_EPI) { if (wr == 0) PG8_BAR; }
    PG8_BAR;
    if constexpr (Epi::AFTER_DRAIN) { E.fused(acc, cur, wr, wc, fr, fq, lds, wid, lane); S.done(cur); }
#undef PG8_SA
#undef PG8_SB
#undef PG8_STAGE
#undef PG8_LDA
#undef PG8_LDB
#undef PG8_MMA
#undef PG8_WAIT_V
#undef PG8_WAIT_L
#undef PG8_BAR
#undef PG8_SCHED
}
}

using pg8::bf16_t; using pg8::bf16x8; using pg8::f32x4; using pg8::u32x4; using pg8::u32x2; using pg8::cvt_pk_bf16; using pg8::fast_sigmoid; using pg8::gelu_tanh;
#define LAS __attribute__((address_space(3)))
constexpr int NWAVES = 8;
constexpr int LDS_BYTES = 147456;
constexpr int T = 16384, M = 32768, D = 1024, FF = 2816, PROJ = 2608, PROJ_PAD = 2816;
constexpr float EPS = 1e-6f;
constexpr size_t MiB = 1u << 20;
constexpr size_t WS_WIN = 0;
constexpr size_t WS_WOUT = 12 * MiB;
constexpr size_t WS_WC1 = 16 * MiB;
constexpr size_t WS_WS5IN = 20 * MiB;
constexpr size_t WS_WGLU = 24 * MiB;
constexpr size_t WS_WGU = 32 * MiB;
constexpr size_t WS_WDN = 76 * MiB;
constexpr size_t WS_B1P = 100 * MiB;
constexpr size_t WS_BAR = 100 * MiB + 65536;
constexpr size_t WS_SS = 101 * MiB;
constexpr size_t WS_XN = 104 * MiB;
constexpr size_t WS_R = 168 * MiB;
constexpr size_t KV_ELEMS = (size_t)8 * T * 64 + 32768;
constexpr size_t R_Q = 0, R_O = 64 * MiB, R_KVR = 128 * MiB;
constexpr size_t R_VST = 226 * MiB, R_VWT = R_VST + KV_ELEMS * 2;
constexpr size_t R_GATES = 260 * MiB, R_HID = 266 * MiB, R_KC = 275 * MiB, R_VCT = 277 * MiB;
constexpr size_t R_U = 0, R_Z = 64 * MiB, R_E = 128 * MiB;
constexpr size_t R_H = 0;
constexpr size_t R_KSF = 280 * MiB, R_KWF = R_KSF + KV_ELEMS * 2;
constexpr size_t WS_END = WS_R + 314 * MiB;
static_assert(R_KWF + KV_ELEMS * 2 <= 314 * MiB, "ws map 2");
static_assert(R_KVR + 6 * KV_ELEMS * 2 <= R_VST && R_VWT + KV_ELEMS * 2 <= R_GATES, "ws map");

struct Params { const float* in[25]; float* out; unsigned char* ws; int ph_lo, ph_hi; };
typedef const __attribute__((address_space(4))) Params* KPtr;
enum { I_X = 0, I_MIXN, I_FFNN, I_NWIN, I_NWOUT, I_QG, I_KG, I_CPOS, I_CW1, I_CB1, I_CW2, I_CB2, I_SWIN, I_SBRE, I_SBIM, I_SCRE, I_SCIM, I_SD, I_SLDT, I_SARE, I_SAIM, I_SWGLU, I_FG, I_FU, I_FD };

__device__ __forceinline__ float bf_lo(unsigned w) { return __uint_as_float(w << 16); }
__device__ __forceinline__ float bf_hi(unsigned w) { return __uint_as_float(w & 0xffff0000u); }
__device__ __forceinline__ float wave_sum(float v) {
#pragma unroll
    for (int o = 1; o < 64; o <<= 1) v += __shfl_xor(v, o);
    return v;
}
__device__ __forceinline__ float red_g(float v) { v += __shfl_xor(v, 16); v += __shfl_xor(v, 32); return v; }
__device__ __forceinline__ unsigned wave_max_u(unsigned v) {
    unsigned w;
    w = (unsigned)__builtin_amdgcn_update_dpp((int)v, (int)v, 0x128, 0xf, 0xf, false); v = w > v ? w : v;
    w = (unsigned)__builtin_amdgcn_update_dpp((int)v, (int)v, 0x124, 0xf, 0xf, false); v = w > v ? w : v;
    w = (unsigned)__builtin_amdgcn_update_dpp((int)v, (int)v, 0x122, 0xf, 0xf, false); v = w > v ? w : v;
    w = (unsigned)__builtin_amdgcn_update_dpp((int)v, (int)v, 0x121, 0xf, 0xf, false); v = w > v ? w : v;
    const unsigned a = (unsigned)__builtin_amdgcn_readlane((int)v, 0), b = (unsigned)__builtin_amdgcn_readlane((int)v, 16), c = (unsigned)__builtin_amdgcn_readlane((int)v, 32), d = (unsigned)__builtin_amdgcn_readlane((int)v, 48);
    const unsigned ab = a > b ? a : b, cd = c > d ? c : d; return ab > cd ? ab : cd;
}
__device__ __forceinline__ bf16x8 pack8(const f32x4& a, const f32x4& b) {
    u32x4 w; w.x = cvt_pk_bf16(a[0], a[1]); w.y = cvt_pk_bf16(a[2], a[3]); w.z = cvt_pk_bf16(b[0], b[1]); w.w = cvt_pk_bf16(b[2], b[3]);
    return __builtin_bit_cast(bf16x8, w);
}
__device__ __forceinline__ bf16x8 ld8(const bf16_t* p) { return *(const bf16x8*)p; }
__device__ __forceinline__ bf16x8 ld4x2(const bf16_t* p0, const bf16_t* p1) { u32x4 w; const u32x2 a = *(const u32x2*)p0, b = *(const u32x2*)p1; w.x = a.x; w.y = a.y; w.z = b.x; w.w = b.y; return __builtin_bit_cast(bf16x8, w); }
#define MFMA16(a, b, c) __builtin_amdgcn_mfma_f32_16x16x32_bf16((a), (b), (c), 0, 0, 0)

struct Job { const float* W; int K, ldw, N, Npad; bf16_t* WT; const float* gain; int map; };
__device__ __forceinline__ void transpose_load(const Job& J, int item, int lane, f32x4 (&v)[8]) {
    const int nblk = J.Npad / 32, kb = item / nblk, nb = item % nblk, k0 = 64 * kb, n0 = 32 * nb;
    const int nn = n0 + 4 * (lane & 7);
#pragma unroll
    for (int r = 0; r < 8; ++r) { const int kk = 8 * r + (lane >> 3); v[r] = (f32x4){0.f, 0.f, 0.f, 0.f}; if (nn < J.N) v[r] = *(const f32x4*)(J.W + (size_t)(k0 + kk) * J.ldw + nn);
        if (J.gain) v[r] = v[r] * J.gain[k0 + kk]; }
}
__device__ __forceinline__ void transpose_store(const Job& J, LAS float* scr, int item, int lane, const f32x4 (&v)[8]) {
    const int nblk = J.Npad / 32, kb = item / nblk, nb = item % nblk, k0 = 64 * kb, n0 = 32 * nb;
#pragma unroll
    for (int r = 0; r < 8; ++r) { const int kk = 8 * r + (lane >> 3); LAS float* sp = scr + kk * 33 + 4 * (lane & 7); sp[0] = v[r][0]; sp[1] = v[r][1]; sp[2] = v[r][2]; sp[3] = v[r][3]; }
    asm volatile("s_waitcnt lgkmcnt(0)" ::: "memory");
    const int c = lane & 7;
#pragma unroll
    for (int j = 0; j < 4; ++j) { const int n = (lane >> 3) + 8 * j; const LAS float* s = scr + (8 * c) * 33 + n;
        u32x4 o; o.x = cvt_pk_bf16(s[0 * 33], s[1 * 33]); o.y = cvt_pk_bf16(s[2 * 33], s[3 * 33]); o.z = cvt_pk_bf16(s[4 * 33], s[5 * 33]); o.w = cvt_pk_bf16(s[6 * 33], s[7 * 33]);
        const int ng = n0 + n; int dr = ng; if (J.map) dr = (ng >> 7) * 256 + (ng & 127) + (J.map == 2 ? 128 : 0);
        *(u32x4*)(J.WT + (size_t)dr * J.K + k0 + 8 * c) = o; }
    asm volatile("s_waitcnt lgkmcnt(0)" ::: "memory");
}
constexpr int NJOBS = 26;
__device__ __forceinline__ void get_job(KPtr p, int j, Job& J) {
    unsigned char* ws = p->ws; J.gain = nullptr; J.map = 0;
    if (j < 8) {
        const int i = j >> 2, s = j & 3;
        if (s == 0) { J.W = p->in[I_NWIN] + (size_t)i * D * PROJ; J.K = D; J.ldw = PROJ; J.N = PROJ; J.Npad = PROJ_PAD; J.WT = (bf16_t*)(ws + WS_WIN + i * 6 * MiB); J.gain = p->in[I_MIXN] + (2 * i) * D; }
        else if (s == 1) { J.W = p->in[I_NWOUT] + (size_t)i * D * D; J.K = D; J.ldw = D; J.N = D; J.Npad = D; J.WT = (bf16_t*)(ws + WS_WOUT + i * 2 * MiB); }
        else { const int kv = s - 2; J.W = p->in[I_CW1] + (size_t)(i * 2 + kv) * 2048 * 256; J.K = 2048; J.ldw = 256; J.N = 256; J.Npad = 256; J.WT = (bf16_t*)(ws + WS_WC1 + (i * 2 + kv) * MiB); }
    } else if (j < 14) {
        const int i = (j - 8) / 3, s = (j - 8) % 3;
        if (s == 0) { J.W = p->in[I_SWIN] + (size_t)i * D * D; J.K = D; J.ldw = D; J.N = D; J.Npad = D; J.WT = (bf16_t*)(ws + WS_WS5IN + i * 2 * MiB); J.gain = p->in[I_MIXN] + (2 * i + 1) * D; }
        else { J.W = p->in[I_SWGLU] + (size_t)i * D * 2048 + (s == 2 ? 1024 : 0); J.K = D; J.ldw = 2048; J.N = 1024; J.Npad = 1024; J.WT = (bf16_t*)(ws + WS_WGLU + i * 4 * MiB); J.map = s; }
    } else {
        const int l = (j - 14) / 3, s = (j - 14) % 3;
        if (s < 2) { J.W = p->in[s == 0 ? I_FG : I_FU] + (size_t)l * D * FF; J.K = D; J.ldw = FF; J.N = FF; J.Npad = FF; J.WT = (bf16_t*)(ws + WS_WGU + l * 11 * MiB); J.gain = p->in[I_FFNN] + l * D; J.map = s + 1; }
        else { J.W = p->in[I_FD] + (size_t)l * FF * D; J.K = FF; J.ldw = D; J.N = D; J.Npad = D; J.WT = (bf16_t*)(ws + WS_WDN + l * 6 * MiB); }
    }
}
__device__ __forceinline__ void prep_phase(KPtr p, LAS unsigned char* lds, int wave, int lane) {
    LAS float* scr = (LAS float*)(lds + wave * 16384);
    const int gw = blockIdx.x * NWAVES + wave, NGW = gridDim.x * NWAVES;
    {
        int j = 0, base = 0; Job J; get_job(p, 0, J); int nitems = (J.K / 64) * (J.Npad / 32);
        int it = gw;
        while (j < NJOBS && it >= base + nitems) { base += nitems; ++j; if (j < NJOBS) { get_job(p, j, J); nitems = (J.K / 64) * (J.Npad / 32); } }
        f32x4 vc[8];
        if (j < NJOBS) transpose_load(J, it - base, lane, vc);
        while (j < NJOBS) {
            const Job Jc = J; const int itc = it - base;
            it += NGW;
            while (j < NJOBS && it >= base + nitems) { base += nitems; ++j; if (j < NJOBS) { get_job(p, j, J); nitems = (J.K / 64) * (J.Npad / 32); } }
            f32x4 vn[8];
            if (j < NJOBS) transpose_load(J, it - base, lane, vn);
            transpose_store(Jc, scr, itc, lane, vc);
#pragma unroll
            for (int r = 0; r < 8; ++r) vc[r] = vn[r];
        }
    }
    { unsigned long long* ss = (unsigned long long*)(p->ws + WS_SS);
      unsigned zz_ = 0u; asm volatile("" : "+v"(zz_));
      for (int e = (gw * 64 + lane) * 2; e < 7 * M; e += NGW * 64 * 2) *(u32x4*)(ss + M + e) = (u32x4){zz_, zz_, zz_, zz_};
      bf16_t* xn = (bf16_t*)(p->ws + WS_XN); const float* x = p->in[I_X];
      for (int m = gw; m < M; m += NGW) {
          const f32x4* xr = (const f32x4*)(x + (size_t)m * D) + lane; u32x2* o = (u32x2*)(xn + (size_t)m * D) + lane; float s = 0.f;
#pragma unroll
          for (int q = 0; q < 4; ++q) { const f32x4 v = xr[64 * q]; s += (v[0] * v[0] + v[1] * v[1]) + (v[2] * v[2] + v[3] * v[3]); u32x2 w; w.x = cvt_pk_bf16(v[0], v[1]); w.y = cvt_pk_bf16(v[2], v[3]); o[64 * q] = w; }
          s = wave_sum(s); if (lane == 0) ss[m] = (unsigned long long)(s * 16777216.0f); } }
    for (int o = gw; o < 1024; o += NGW) {
        const int ik = o >> 8, jj = o & 255;
        const float* pos = p->in[I_CPOS] + (size_t)ik * 2048; const float* w1 = p->in[I_CW1] + (size_t)ik * 2048 * 256;
        float s = 0.f;
        for (int k = lane; k < 2048; k += 64) s += pos[k] * w1[(size_t)k * 256 + jj];
        s = wave_sum(s);
        if (lane == 0) ((float*)(p->ws + WS_B1P))[o] = s + p->in[I_CB1][o];
    }
}

__device__ __forceinline__ void norm_phase(const float* x, bf16_t* xn, int wave, int lane) {
    const int gw = blockIdx.x * NWAVES + wave, NGW = gridDim.x * NWAVES;
    for (int m = gw; m < M; m += NGW) {
        const f32x4* xr = (const f32x4*)(x + (size_t)m * D) + lane;
        f32x4 v[4]; float s = 0.f;
#pragma unroll
        for (int j = 0; j < 4; ++j) { v[j] = xr[64 * j]; s += (v[j][0] * v[j][0] + v[j][1] * v[j][1]) + (v[j][2] * v[j][2] + v[j][3] * v[j][3]); }
        const float r = 1.0f / sqrtf(wave_sum(s) * (1.f / D) + EPS);
        u32x2* o = (u32x2*)(xn + (size_t)m * D) + lane;
#pragma unroll
        for (int j = 0; j < 4; ++j) { u32x2 w; w.x = cvt_pk_bf16(v[j][0] * r, v[j][1] * r); w.y = cvt_pk_bf16(v[j][2] * r, v[j][3] * r); o[64 * j] = w; }
    }
}

__device__ __forceinline__ void side_phase(KPtr p, int i, int sw, int NSW, LAS unsigned char* lds, int wave, int lane) {
    unsigned char* R = p->ws + WS_R;
    bf16_t* Qb = (bf16_t*)(R + R_Q); bf16_t* KVR = (bf16_t*)(R + R_KVR);
    const int NQ = M * 16, NK = 8 * T;
    const int sub = lane & 7;
    for (int it = sw; it < (NQ + 2 * NK) / 8; it += NSW) {
        const int r8 = it * 8 + (lane >> 3);
        bf16_t* ptr; bf16_t* dptr; const float* gain; float sc = 1.f;
        if (r8 < NQ) { ptr = Qb + (size_t)r8 * 64; dptr = ptr + sub * 8; gain = p->in[I_QG] + i * 64; sc = 0.18033688011112042f;     }
        else { const bool isw = r8 >= NQ + NK; const int rk = r8 - NQ - (isw ? NK : 0);
            ptr = KVR + (size_t)(isw ? 4 : 2) * KV_ELEMS + (size_t)rk * 64; gain = p->in[I_KG] + (i * 3 + (isw ? 2 : 1)) * 64;
            dptr = (bf16_t*)(R + (isw ? R_KWF : R_KSF)) + (size_t)(rk >> 4) * 1024 + (sub >> 2) * 512 + (sub & 3) * 128 + (rk & 15) * 8; }
        const u32x4 w = *(const u32x4*)(ptr + sub * 8);
        float v[8] = {bf_lo(w.x), bf_hi(w.x), bf_lo(w.y), bf_hi(w.y), bf_lo(w.z), bf_hi(w.z), bf_lo(w.w), bf_hi(w.w)};
        float ss = 0.f;
#pragma unroll
        for (int e = 0; e < 8; ++e) ss += v[e] * v[e];
        ss += __shfl_xor(ss, 1); ss += __shfl_xor(ss, 2); ss += __shfl_xor(ss, 4);
        const float r = sc / sqrtf(ss * (1.f / 64.f) + EPS);
        const f32x4 g0 = *(const f32x4*)(gain + sub * 8), g1 = *(const f32x4*)(gain + sub * 8 + 4);
        u32x4 o; o.x = cvt_pk_bf16(v[0] * r * g0[0], v[1] * r * g0[1]); o.y = cvt_pk_bf16(v[2] * r * g0[2], v[3] * r * g0[3]);
        o.z = cvt_pk_bf16(v[4] * r * g1[0], v[5] * r * g1[1]); o.w = cvt_pk_bf16(v[6] * r * g1[2], v[7] * r * g1[3]);
        *(u32x4*)dptr = o;
    }
    LAS bf16_t* tile = (LAS bf16_t*)(lds + wave * 16384);
    for (int it = sw; it < 4096; it += NSW) {
        const int ten = it >> 11, bgt = (it >> 8) & 7, tt = it & 255;
        const bf16_t* src = KVR + (size_t)(ten == 0 ? 3 : 5) * KV_ELEMS + ((size_t)bgt * T + tt * 64) * 64;
        bf16_t* dst = (bf16_t*)(R + (ten == 0 ? R_VST : R_VWT)) + ((size_t)bgt * T + tt * 64) * 64;
#pragma unroll
        for (int r = 0; r < 8; ++r) { const int e = r * 64 + lane; const int row = e >> 3, ch = e & 7; const u32x4 w = *(const u32x4*)(src + (size_t)e * 8);
            LAS unsigned* tp = (LAS unsigned*)(tile + row * 66 + ch * 8); tp[0] = w.x; tp[1] = w.y; tp[2] = w.z; tp[3] = w.w; }
        asm volatile("s_waitcnt lgkmcnt(0)" ::: "memory");
#pragma unroll
        for (int r = 0; r < 8; ++r) { const int kg = r >> 2, dt = r & 3, d = 16 * dt + (lane & 15), tb = 32 * kg + 4 * (lane >> 4); unsigned short h[8];
#pragma unroll
            for (int j = 0; j < 8; ++j) h[j] = tile[(tb + (j & 3) + (j >> 2) * 16) * 66 + d];
            u32x4 o; o.x = h[0] | ((unsigned)h[1] << 16); o.y = h[2] | ((unsigned)h[3] << 16); o.z = h[4] | ((unsigned)h[5] << 16); o.w = h[6] | ((unsigned)h[7] << 16);
            *(u32x4*)(dst + r * 512 + lane * 8) = o; }
        asm volatile("s_waitcnt lgkmcnt(0)" ::: "memory");
    }
}

__device__ __forceinline__ void cmp2_phase(KPtr p, int i, int wave, int lane) {
    unsigned char* R = p->ws + WS_R;
    const int gw = blockIdx.x * NWAVES + wave, NGW = gridDim.x * NWAVES;
    const int fr = lane & 15, G = lane >> 4;
    for (int u = gw; u < 1024; u += NGW) {
        const int kv = u >> 9, r0 = (u & 511) * 16;
        const bf16_t* Hid = (const bf16_t*)(R + R_HID) + (size_t)kv * 8192 * 256;
        const float* w2 = p->in[I_CW2] + (size_t)(i * 2 + kv) * 256 * 64; const float* b2 = p->in[I_CB2] + (i * 2 + kv) * 64;
        f32x4 acc[4];
#pragma unroll
        for (int nt = 0; nt < 4; ++nt) acc[nt] = (f32x4){0.f, 0.f, 0.f, 0.f};
        for (int ks = 0; ks < 8; ++ks) {
            const bf16x8 a = ld8(Hid + (size_t)(r0 + fr) * 256 + ks * 32 + G * 8);
#pragma unroll
            for (int nt = 0; nt < 4; ++nt) { const float* wp = w2 + (size_t)(ks * 32 + G * 8) * 64 + nt * 16 + fr;
                u32x4 w; w.x = cvt_pk_bf16(wp[0], wp[64]); w.y = cvt_pk_bf16(wp[128], wp[192]); w.z = cvt_pk_bf16(wp[256], wp[320]); w.w = cvt_pk_bf16(wp[384], wp[448]);
                acc[nt] = MFMA16(a, __builtin_bit_cast(bf16x8, w), acc[nt]); }
        }
#pragma unroll
        for (int nt = 0; nt < 4; ++nt) { const float bv = b2[nt * 16 + fr]; acc[nt] = acc[nt] + bv; }
        if (kv == 0) {
            bf16_t* KC = (bf16_t*)(R + R_KC); const float* kg = p->in[I_KG] + (i * 3 + 0) * 64;
#pragma unroll
            for (int r = 0; r < 4; ++r) { float ss = 0.f;
#pragma unroll
                for (int nt = 0; nt < 4; ++nt) ss += acc[nt][r] * acc[nt][r];
                ss += __shfl_xor(ss, 1); ss += __shfl_xor(ss, 2); ss += __shfl_xor(ss, 4); ss += __shfl_xor(ss, 8);
                const float rr = 1.0f / sqrtf(ss * (1.f / 64.f) + EPS);
#pragma unroll
                for (int nt = 0; nt < 4; ++nt) { const unsigned w = cvt_pk_bf16(acc[nt][r] * rr * kg[nt * 16 + fr], 0.f); const int n = r0 + 4 * G + r, d = nt * 16 + fr; KC[(size_t)(n >> 4) * 1024 + (d >> 5) * 512 + ((d >> 3) & 3) * 128 + (n & 15) * 8 + (d & 7)] = (bf16_t)(w & 0xffffu); } }
        } else {
            bf16_t* VCT = (bf16_t*)(R + R_VCT); const int rr0 = r0 + 4 * G, bgc = rr0 >> 10, n = rr0 & 1023;
#pragma unroll
            for (int nt = 0; nt < 4; ++nt) { u32x2 w; w.x = cvt_pk_bf16(acc[nt][0], acc[nt][1]); w.y = cvt_pk_bf16(acc[nt][2], acc[nt][3]);
                *(u32x2*)(VCT + (size_t)bgc * 65536 + (size_t)((n >> 5) * 4 + nt) * 512 + (G * 16 + fr) * 8 + ((n >> 4) & 1) * 4) = w; }
        }
    }
}

struct AttnT { const bf16_t *Q, *KC, *VCT, *KS, *VST, *KW, *VWT; const float* gates; bf16_t* O; };
constexpr int OS = 260;
__device__ __forceinline__ bf16x8 ldg8(const char* ub, unsigned off) { return *(const bf16x8*)(ub + off); }
__device__ __forceinline__ float ex2(float x) { return __builtin_amdgcn_exp2f(x); }
__device__ __forceinline__ void attn_unit(const AttnT& A, int bg, int qt, LAS float* wl, int lane) {
    const int fr = lane & 15, G = lane >> 4;
    const int b = bg >> 2, g = bg & 3, t0 = qt * 16;
    LAS unsigned* hm = (LAS unsigned*)(wl + 16 * OS);
    const f32x4 z4 = (f32x4){0.f, 0.f, 0.f, 0.f};
    const unsigned koff = lane * 16;
    const char* Qu = (const char*)(A.Q + ((size_t)b * T + t0) * 1024 + g * 256);
    const char* Gu = (const char*)(A.gates + ((size_t)b * T + t0) * 48 + g * 12);
    char* Ou = (char*)(A.O + ((size_t)b * T + t0) * 1024 + g * 256);
    float il[4] = {0.f, 0.f, 0.f, 0.f};
    const int ntile_c = (qt + 15) >> 4, npair_c = (ntile_c + 1) >> 1;
    const int lim = qt - 1;
    const char* KCb = (const char*)(A.KC + (size_t)bg * 1024 * 64); const char* VCb = (const char*)(A.VCT + (size_t)bg * 64 * 1024);
    if (qt > 0) {
        bf16x8 qf[4][2];
#pragma unroll
        for (int hh = 0; hh < 4; ++hh)
#pragma unroll
            for (int ks = 0; ks < 2; ++ks) qf[hh][ks] = ldg8(Qu, fr * 2048 + hh * 128 + ks * 64 + G * 16);
        float ls[4] = {0.f, 0.f, 0.f, 0.f};
        bf16x8 kr0[4], kr1[4];
#pragma unroll
        for (int d = 0; d < 4; ++d) { const int t = d < ntile_c ? d : ntile_c - 1; kr0[d] = ldg8(KCb + t * 2048, koff); kr1[d] = ldg8(KCb + t * 2048 + 1024, koff); }
#pragma unroll 1
        for (int tl4 = 0; tl4 < ntile_c; tl4 += 4) {
#pragma unroll
            for (int d = 0; d < 4; ++d) {
                const int tl = tl4 + d;
                if (tl < ntile_c) {
                    const int n0 = tl * 16; const bf16x8 k0 = kr0[d], k1 = kr1[d];
                    if (n0 + 15 < lim) {
#pragma unroll
                        for (int hh = 0; hh < 4; ++hh) { f32x4 s = MFMA16(k0, qf[hh][0], z4); s = MFMA16(k1, qf[hh][1], s); ls[hh] += (ex2(s[0]) + ex2(s[1])) + (ex2(s[2]) + ex2(s[3])); }
                    } else {
#pragma unroll
                        for (int hh = 0; hh < 4; ++hh) { f32x4 s = MFMA16(k0, qf[hh][0], z4); s = MFMA16(k1, qf[hh][1], s);
#pragma unroll
                            for (int r = 0; r < 4; ++r) { const int n = n0 + 4 * G + r; const bool valid = (n < lim) || (fr == 15 && n == lim); ls[hh] += valid ? ex2(s[r]) : 0.f; } }
                    }
                    const int tn = tl + 4 < ntile_c ? tl + 4 : ntile_c - 1;
                    kr0[d] = ldg8(KCb + tn * 2048, koff); kr1[d] = ldg8(KCb + tn * 2048 + 1024, koff);
                }
            }
        }
#pragma unroll
        for (int hh = 0; hh < 4; ++hh) { const float l = red_g(ls[hh]); il[hh] = l > 0.f ? 1.0f / l : 0.f; }
    }
#pragma unroll 1
    for (int hp = 0; hp < 2; ++hp) {
        f32x4 acc[2][4];
#pragma unroll
        for (int hh = 0; hh < 2; ++hh)
#pragma unroll
            for (int dt = 0; dt < 4; ++dt) acc[hh][dt] = z4;
        if (qt > 0) {
            bf16x8 qf[2][2];
#pragma unroll
            for (int hh = 0; hh < 2; ++hh)
#pragma unroll
                for (int ks = 0; ks < 2; ++ks) qf[hh][ks] = ldg8(Qu + hp * 256, fr * 2048 + hh * 128 + ks * 64 + G * 16);
            const float ilp[2] = {hp ? il[2] : il[0], hp ? il[3] : il[1]};
            float carry = 0.f;
            bf16x8 ka0 = ldg8(KCb, koff), ka1 = ldg8(KCb + 1024, koff), kb0 = ldg8(KCb + 2048, koff), kb1 = ldg8(KCb + 3072, koff);
            bf16x8 vfc[4];
#pragma unroll
            for (int dt = 0; dt < 4; ++dt) vfc[dt] = ldg8(VCb + dt * 1024, koff);
            for (int pr = 0; pr < npair_c; ++pr) {
                const int n0 = pr * 32; const int pn = pr + 1 < npair_c ? pr + 1 : pr;
                const bf16x8 na0 = ldg8(KCb + pn * 4096, koff), na1 = ldg8(KCb + pn * 4096 + 1024, koff), nb0 = ldg8(KCb + pn * 4096 + 2048, koff), nb1 = ldg8(KCb + pn * 4096 + 3072, koff);
                bf16x8 nvf[4];
#pragma unroll
                for (int dt = 0; dt < 4; ++dt) nvf[dt] = ldg8(VCb + (pn * 4 + dt) * 1024, koff);
                bf16x8 pf[2]; f32x4 psa = z4, psb = z4;
                const bool fullc = n0 + 31 < lim;
#pragma unroll
                for (int hh = 0; hh < 2; ++hh) { f32x4 sa = MFMA16(ka0, qf[hh][0], z4); sa = MFMA16(ka1, qf[hh][1], sa); f32x4 sb = MFMA16(kb0, qf[hh][0], z4); sb = MFMA16(kb1, qf[hh][1], sb);
                    if (fullc) {
#pragma unroll
                        for (int r = 0; r < 4; ++r) { sa[r] = ex2(sa[r]) * ilp[hh]; sb[r] = ex2(sb[r]) * ilp[hh]; }
                    } else {
#pragma unroll
                        for (int r = 0; r < 4; ++r) { const int n = n0 + 4 * G + r; const bool va = (n < lim) || (fr == 15 && n == lim), vb = (n + 16 < lim) || (fr == 15 && n + 16 == lim);
                            sa[r] = va ? ex2(sa[r]) * ilp[hh] : 0.f; sb[r] = vb ? ex2(sb[r]) * ilp[hh] : 0.f; }
                    }
                    psa = psa + sa; psb = psb + sb; pf[hh] = pack8(sa, sb); }
                {
                    const float ta = psa[3], tb = psb[3];
                    const float upa = __shfl(ta, (lane + 48) & 63), nca = __shfl(ta, 48 + fr), upb = __shfl(tb, (lane + 48) & 63), ncb = __shfl(tb, 48 + fr);
                    const float va = (psa[0] + psa[1]) + (psa[2] + psa[3]) + ((G == 0) ? carry : upa);
                    const float vb = (psb[0] + psb[1]) + (psb[2] + psb[3]) + ((G == 0) ? nca : upb);
                    carry = ncb;
                    LAS float* w0 = wl + fr * OS + pr * 8 + G;
                    if (hp == 0) { w0[0] = va; w0[4] = vb; } else { w0[0] += va; w0[4] += vb; }
                }
#pragma unroll
                for (int dt = 0; dt < 4; ++dt) {
#pragma unroll
                    for (int hh = 0; hh < 2; ++hh) acc[hh][dt] = MFMA16(vfc[dt], pf[hh], acc[hh][dt]); }
                ka0 = na0; ka1 = na1; kb0 = nb0; kb1 = nb1;
#pragma unroll
                for (int dt = 0; dt < 4; ++dt) vfc[dt] = nvf[dt];
            }
        }
#pragma unroll
        for (int hh = 0; hh < 2; ++hh) { const float gc = *(const float*)(Gu + fr * 192 + (hp * 2 + hh) * 12);
#pragma unroll
            for (int dt = 0; dt < 4; ++dt) { const f32x4 o = acc[hh][dt] * gc; u32x2 w; w.x = cvt_pk_bf16(o[0], o[1]); w.y = cvt_pk_bf16(o[2], o[3]);
                *(u32x2*)(Ou + fr * 2048 + ((hp * 2 + hh) * 64 + dt * 16 + G * 4) * 2) = w; } }
    }
    hm[lane] = 0u; hm[64 + lane] = 0u;
    {
        const int cur = t0 >> 6;
        if (lane == 0) {
            __hip_atomic_fetch_or(hm, 0xffffu, __ATOMIC_RELAXED, __HIP_MEMORY_SCOPE_WORKGROUP);
            if (cur >= 1) __hip_atomic_fetch_or(hm + (cur >> 1), 0xffffu << ((cur & 1) * 16), __ATOMIC_RELAXED, __HIP_MEMORY_SCOPE_WORKGROUP);
            if (cur >= 2) __hip_atomic_fetch_or(hm + ((cur - 1) >> 1), 0xffffu << (((cur - 1) & 1) * 16), __ATOMIC_RELAXED, __HIP_MEMORY_SCOPE_WORKGROUP);
        }
        if (cur >= 3) {
            const int nfree = 13;
#pragma unroll 1
            for (int i0 = 0; i0 < 4; ++i0) {
                unsigned key[4][4];
#pragma unroll
                for (int qq = 0; qq < 4; ++qq) { const f32x4 v = *(const LAS f32x4*)(wl + (i0 + 4 * qq) * OS + lane * 4);
#pragma unroll
                    for (int c = 0; c < 4; ++c) { const int s = lane * 4 + c;
                        const unsigned k = (__float_as_uint(fmaxf(v[c], 1e-30f)) & 0xffffff00u) | (unsigned)(255 - s); key[qq][c] = (s >= 1 && s <= cur - 2) ? k : 0u; } }
#pragma unroll 1
                for (int it = 0; it < nfree; ++it) {
                    unsigned mm[4];
#pragma unroll
                    for (int qq = 0; qq < 4; ++qq) { unsigned m = key[qq][0] > key[qq][1] ? key[qq][0] : key[qq][1]; const unsigned m2 = key[qq][2] > key[qq][3] ? key[qq][2] : key[qq][3]; mm[qq] = m > m2 ? m : m2; }
#pragma unroll
                    for (int qq = 0; qq < 4; ++qq) mm[qq] = wave_max_u(mm[qq]);
                    if ((mm[0] | mm[1] | mm[2] | mm[3]) == 0u) break;
#pragma unroll
                    for (int qq = 0; qq < 4; ++qq) {
                        if (mm[qq] != 0u) { const int sidx = 255 - (int)(mm[qq] & 255u);
                            if (lane == 0) __hip_atomic_fetch_or(hm + (sidx >> 1), 1u << ((sidx & 1) * 16 + i0 + 4 * qq), __ATOMIC_RELAXED, __HIP_MEMORY_SCOPE_WORKGROUP);
#pragma unroll
                            for (int c = 0; c < 4; ++c) key[qq][c] = (lane * 4 + c == sidx) ? 0u : key[qq][c]; }
                    }
                }
            }
        }
    }
#pragma unroll 1
    for (int hp = 0; hp < 2; ++hp) {
        bf16x8 qf[2][2];
#pragma unroll
        for (int hh = 0; hh < 2; ++hh)
#pragma unroll
            for (int ks = 0; ks < 2; ++ks) qf[hh][ks] = ldg8(Qu + hp * 256, fr * 2048 + hh * 128 + ks * 64 + G * 16);
        f32x4 acc[2][4];
#pragma unroll
        for (int hh = 0; hh < 2; ++hh)
#pragma unroll
            for (int dt = 0; dt < 4; ++dt) acc[hh][dt] = z4;
        const char* KWb = (const char*)(A.KW + (size_t)bg * T * 64); const char* VWb = (const char*)(A.VWT + (size_t)bg * 64 * T);
        int kstart = (t0 - 528) & ~31; if (kstart < 0) kstart = 0;
        const int ntile = (t0 + 16 - kstart) >> 4, npair = (ntile + 1) >> 1;
        float ls[2] = {0.f, 0.f};
        const int tq = t0 + fr;
        bf16x8 ka0 = ldg8(KWb + kstart * 128, koff), ka1 = ldg8(KWb + kstart * 128 + 1024, koff), kb0 = ldg8(KWb + kstart * 128 + 2048, koff), kb1 = ldg8(KWb + kstart * 128 + 3072, koff);
        bf16x8 vfw[4];
#pragma unroll
        for (int dt = 0; dt < 4; ++dt) vfw[dt] = ldg8(VWb + kstart * 128 + dt * 1024, koff);
        for (int pr = 0; pr < npair; ++pr) {
            const int k0p = kstart + pr * 32; const int k0n = pr + 1 < npair ? k0p + 32 : k0p;
            const bf16x8 na0 = ldg8(KWb + k0n * 128, koff), na1 = ldg8(KWb + k0n * 128 + 1024, koff), nb0 = ldg8(KWb + k0n * 128 + 2048, koff), nb1 = ldg8(KWb + k0n * 128 + 3072, koff);
            bf16x8 nvf[4];
#pragma unroll
            for (int dt = 0; dt < 4; ++dt) nvf[dt] = ldg8(VWb + k0n * 128 + dt * 1024, koff);
            const bool full = (k0p + 31 <= t0) && (t0 + 15 - k0p < 512);
            bf16x8 pf[2];
#pragma unroll
            for (int hh = 0; hh < 2; ++hh) { f32x4 sa = MFMA16(ka0, qf[hh][0], z4); sa = MFMA16(ka1, qf[hh][1], sa); f32x4 sb = MFMA16(kb0, qf[hh][0], z4); sb = MFMA16(kb1, qf[hh][1], sb);
                if (full) {
#pragma unroll
                    for (int r = 0; r < 4; ++r) { sa[r] = ex2(sa[r]); sb[r] = ex2(sb[r]); }
                } else {
#pragma unroll
                    for (int r = 0; r < 4; ++r) { const int kp = k0p + 4 * G + r; const bool va = (kp <= tq && tq - kp < 512), vb = (kp + 16 <= tq && tq - kp - 16 < 512);
                        sa[r] = va ? ex2(sa[r]) : 0.f; sb[r] = vb ? ex2(sb[r]) : 0.f; }
                }
                ls[hh] += ((sa[0] + sa[1]) + (sa[2] + sa[3])) + ((sb[0] + sb[1]) + (sb[2] + sb[3]));
                pf[hh] = pack8(sa, sb); }
#pragma unroll
            for (int dt = 0; dt < 4; ++dt) {
#pragma unroll
                for (int hh = 0; hh < 2; ++hh) acc[hh][dt] = MFMA16(vfw[dt], pf[hh], acc[hh][dt]); }
            ka0 = na0; ka1 = na1; kb0 = nb0; kb1 = nb1;
#pragma unroll
            for (int dt = 0; dt < 4; ++dt) vfw[dt] = nvf[dt];
        }
#pragma unroll
        for (int hh = 0; hh < 2; ++hh) { const float sc = *(const float*)(Gu + fr * 192 + (hp * 2 + hh) * 12 + 8) / red_g(ls[hh]);
#pragma unroll
            for (int dt = 0; dt < 4; ++dt) *(LAS f32x4*)(wl + fr * OS + (hp * 2 + hh) * 64 + dt * 16 + G * 4) = acc[hh][dt] * sc; }
    }
    {
        const char* KSb = (const char*)(A.KS + (size_t)bg * T * 64); const char* VSb = (const char*)(A.VST + (size_t)bg * 64 * T);
        const int cur = t0 >> 6;
        const int cq = fr >> 2, ch = fr & 3;
        bf16x8 qs[4][2];
#pragma unroll
        for (int qg = 0; qg < 4; ++qg)
#pragma unroll
            for (int ks = 0; ks < 2; ++ks) qs[qg][ks] = ldg8(Qu, (4 * qg + cq) * 2048 + ch * 128 + ks * 64 + G * 16);
        f32x4 acc[4][4]; float ls[4] = {0.f, 0.f, 0.f, 0.f};
#pragma unroll
        for (int qg = 0; qg < 4; ++qg)
#pragma unroll
            for (int dt = 0; dt < 4; ++dt) acc[qg][dt] = z4;
        int s = 0; unsigned m = 0xffffu;
#pragma unroll 1
        while (s <= cur) {
            bf16x8 kf[4], kg[4], vf[8];
#pragma unroll
            for (int c = 0; c < 4; ++c) kf[c] = ldg8(KSb + (size_t)s * 8192 + c * 1024, koff);
#pragma unroll
            for (int c = 0; c < 4; ++c) kg[c] = ldg8(KSb + (size_t)s * 8192 + 4096 + c * 1024, koff);
#pragma unroll
            for (int c = 0; c < 8; ++c) vf[c] = ldg8(VSb + (size_t)s * 8192 + c * 1024, koff);
            int sn = s + 1; unsigned mn = 0u;
            while (sn <= cur) { mn = ((unsigned)__builtin_amdgcn_readfirstlane((int)hm[sn >> 1]) >> ((sn & 1) * 16)) & 0xffffu; if (mn) break; ++sn; }
            const bool part = (s == cur);
#pragma unroll
            for (int qg = 0; qg < 4; ++qg) {
                if (((m >> (4 * qg)) & 0xfu) == 0u) continue;
                const bool hit = ((m >> (4 * qg + cq)) & 1u) != 0u;
                const int tq = t0 + 4 * qg + cq;
#pragma unroll
                for (int pq = 0; pq < 2; ++pq) {
                    f32x4 sa = MFMA16(pq ? kg[0] : kf[0], qs[qg][0], z4); sa = MFMA16(pq ? kg[1] : kf[1], qs[qg][1], sa);
                    f32x4 sb = MFMA16(pq ? kg[2] : kf[2], qs[qg][0], z4); sb = MFMA16(pq ? kg[3] : kf[3], qs[qg][1], sb);
                    if (part) {
#pragma unroll
                        for (int r = 0; r < 4; ++r) { const int kp = s * 64 + pq * 32 + 4 * G + r; const bool va = hit && kp <= tq, vb = hit && kp + 16 <= tq;
                            sa[r] = va ? ex2(sa[r]) : 0.f; sb[r] = vb ? ex2(sb[r]) : 0.f; }
                    } else {
#pragma unroll
                        for (int r = 0; r < 4; ++r) { sa[r] = hit ? ex2(sa[r]) : 0.f; sb[r] = hit ? ex2(sb[r]) : 0.f; }
                    }
                    ls[qg] += ((sa[0] + sa[1]) + (sa[2] + sa[3])) + ((sb[0] + sb[1]) + (sb[2] + sb[3]));
                    const bf16x8 pf = pack8(sa, sb);
#pragma unroll
                    for (int dt = 0; dt < 4; ++dt) acc[qg][dt] = MFMA16(vf[pq * 4 + dt], pf, acc[qg][dt]);
                }
            }
            s = sn; m = mn;
        }
#pragma unroll
        for (int qg = 0; qg < 4; ++qg) { const float sc = *(const float*)(Gu + (4 * qg + cq) * 192 + ch * 12 + 4) / red_g(ls[qg]);
#pragma unroll
            for (int dt = 0; dt < 4; ++dt) { LAS f32x4* op = (LAS f32x4*)(wl + (4 * qg + cq) * OS + ch * 64 + dt * 16 + G * 4); *op = *op + acc[qg][dt] * sc; } }
    }
    asm volatile("s_waitcnt vmcnt(0)" ::: "memory");
#pragma unroll 4
    for (int q = 0; q < 16; ++q) { const f32x4 v = *(const LAS f32x4*)(wl + q * OS + lane * 4); const u32x2 pw = *(const u32x2*)(Ou + q * 2048 + lane * 8); u32x2 w;
        w.x = cvt_pk_bf16(v[0] + bf_lo(pw.x), v[1] + bf_hi(pw.x)); w.y = cvt_pk_bf16(v[2] + bf_lo(pw.y), v[3] + bf_hi(pw.y));
        *(u32x2*)(Ou + q * 2048 + lane * 8) = w; }
}
__device__ __forceinline__ void attn_phase(KPtr p, int i, LAS unsigned char* lds, int wave, int lane) {
    unsigned char* R = p->ws + WS_R; const bf16_t* KVR = (const bf16_t*)(R + R_KVR);
    AttnT A; A.Q = (const bf16_t*)(R + R_Q); A.KC = (const bf16_t*)(R + R_KC); A.VCT = (const bf16_t*)(R + R_VCT); A.KS = (const bf16_t*)(R + R_KSF); A.VST = (const bf16_t*)(R + R_VST);
    A.KW = (const bf16_t*)(R + R_KWF); A.VWT = (const bf16_t*)(R + R_VWT); A.gates = (const float*)(R + R_GATES); A.O = (bf16_t*)(R + R_O);
    LAS float* wl = (LAS float*)(lds + wave * 17408);
    const bool xa = (gridDim.x & 7) == 0;
    unsigned* cnt = (unsigned*)(p->ws + WS_BAR + 16384) + (size_t)(i * 8 + (xa ? (int)(blockIdx.x & 7) : 0)) * 64;
    const unsigned total = xa ? 1024u : 8192u;
#pragma unroll 1
    for (;;) {
        unsigned idx = 0u; if (lane == 0) idx = atomicAdd(cnt, 1u);
        idx = (unsigned)__builtin_amdgcn_readfirstlane((int)idx);
        if (idx >= total) break;
        int bg, qt;
        if (xa) { bg = blockIdx.x & 7; qt = 1023 - (int)idx; } else { bg = (int)(idx & 7u); qt = 1023 - (int)(idx >> 3); }
        attn_unit(A, bg, qt, wl, lane);
    }
}

constexpr int CH = 128, NCH = T / CH;
typedef float f32x2s __attribute__((ext_vector_type(2)));
template <bool FINAL>
__device__ __forceinline__ void scan_phase(KPtr p, int i, LAS unsigned char* lds, int wave, int lane) {
    unsigned char* R = p->ws + WS_R;
    const bf16_t* U = (const bf16_t*)(R + R_U); bf16_t* Z = (bf16_t*)(R + R_Z); float* E = (float*)(R + R_E);
    LAS bf16_t* xt = (LAS bf16_t*)(lds + wave * 17408);
    const int gw = blockIdx.x * NWAVES + wave, NGW = gridDim.x * NWAVES;
    const int pl = lane & 15, G = lane >> 4;
    const f32x4 z4 = (f32x4){0.f, 0.f, 0.f, 0.f};
#pragma unroll 1
    for (int u = gw, it_ = 0; u < 2 * 32 * 64; u += NGW, ++it_) {
        const int g = u & 63, b = u >> 11; const int q = ((it_ & 1) && (NGW % 2048 == 0)) ? 31 - ((u >> 6) & 31) : ((u >> 6) & 31);
        const int ch = 4 * q + G;
        const float dt = __expf(p->in[I_SLDT][i * 64 + g]);
        f32x2s ab_r[4], ab_i[4]; bf16x8 bfr[4], bfi[4];
#pragma unroll
        for (int j = 0; j < 4; ++j) {
            const int sidx = (i * 64 + g) * 64 + 16 * j + pl;
            const float ar = p->in[I_SARE][sidx], ai = p->in[I_SAIM][sidx];
            const float mag = expf(dt * ar); float sn, cs; sincosf(dt * ai, &sn, &cs);
            const float abr = mag * cs, abi = mag * sn, den = ar * ar + ai * ai;
            const float cr = ((abr - 1.0f) * ar + abi * ai) / den, ci = (abi * ar - (abr - 1.0f) * ai) / den;
            ab_r[j] = (f32x2s){abr, abr}; ab_i[j] = (f32x2s){-abi, abi};
            f32x4 r0, r1, i0, i1;
            { const f32x4* brp = (const f32x4*)(p->in[I_SBRE] + (size_t)sidx * 16 + 8 * (G & 1)); const f32x4* bip = (const f32x4*)(p->in[I_SBIM] + (size_t)sidx * 16 + 8 * (G & 1));
                const f32x4 br0 = brp[0], br1 = brp[1], bi0 = bip[0], bi1 = bip[1]; const float km = (G < 2) ? 1.f : 0.f;
                r0 = (br0 * cr - bi0 * ci) * km; r1 = (br1 * cr - bi1 * ci) * km; i0 = (bi0 * cr + br0 * ci) * km; i1 = (bi1 * cr + br1 * ci) * km; }
            bfr[j] = pack8(r0, r1); bfi[j] = pack8(i0, i1);
        }
        f32x2s x[4] = {(f32x2s){0.f, 0.f}, (f32x2s){0.f, 0.f}, (f32x2s){0.f, 0.f}, (f32x2s){0.f, 0.f}};
        bf16x8 cf[4]; float dsk = 0.f;
        if (FINAL) {
            float pw_r[4], pw_i[4], cr_[4] = {0.f, 0.f, 0.f, 0.f}, ci_[4] = {0.f, 0.f, 0.f, 0.f};
#pragma unroll
            for (int j = 0; j < 4; ++j) { float pr_ = ab_r[j][0], pi_ = ab_i[j][1];
#pragma unroll
                for (int s = 0; s < 7; ++s) { const float nr = pr_ * pr_ - pi_ * pi_, ni = 2.f * pr_ * pi_; pr_ = nr; pi_ = ni; }
                pw_r[j] = pr_; pw_i[j] = pi_; }
            const float2* Ep = (const float2*)E + ((size_t)b * NCH * 64 + g) * 64 + pl;
            int c = 0;
#pragma unroll 1
            for (; c + 8 <= ch; c += 8) { float2 e[8][4];
#pragma unroll
                for (int s = 0; s < 8; ++s)
#pragma unroll
                    for (int j = 0; j < 4; ++j) e[s][j] = Ep[(size_t)(c + s) * 4096 + 16 * j];
#pragma unroll
                for (int s = 0; s < 8; ++s)
#pragma unroll
                    for (int j = 0; j < 4; ++j) { const float nr = pw_r[j] * cr_[j] - pw_i[j] * ci_[j] + e[s][j].x, ni = pw_r[j] * ci_[j] + pw_i[j] * cr_[j] + e[s][j].y; cr_[j] = nr; ci_[j] = ni; } }
#pragma unroll 1
            for (; c < ch; ++c) {
#pragma unroll
                for (int j = 0; j < 4; ++j) { const float2 e = Ep[(size_t)c * 4096 + 16 * j]; const float nr = pw_r[j] * cr_[j] - pw_i[j] * ci_[j] + e.x, ni = pw_r[j] * ci_[j] + pw_i[j] * cr_[j] + e.y; cr_[j] = nr; ci_[j] = ni; } }
#pragma unroll
            for (int j = 0; j < 4; ++j) x[j] = (f32x2s){cr_[j], ci_[j]};
#pragma unroll
            for (int ks = 0; ks < 4; ++ks) { const float* cp = p->in[ks < 2 ? I_SCRE : I_SCIM] + ((size_t)(i * 64 + g) * 16 + pl) * 64 + (ks & 1) * 32 + G * 8; const float sg = ks < 2 ? 1.f : -1.f;
                const f32x4 c0 = *(const f32x4*)cp * sg, c1 = *(const f32x4*)(cp + 4) * sg; cf[ks] = pack8(c0, c1); }
            dsk = p->in[I_SD][i * 1024 + g * 16 + pl];
        }
        const bf16_t* Ua = U + ((size_t)b * T + (size_t)(4 * q + (pl >> 2)) * CH + (pl & 3)) * 1024 + g * 16 + 8 * (G & 1);
        bf16x8 an[4];
#pragma unroll
        for (int st = 0; st < 4; ++st) an[st] = ld8(Ua + (size_t)(st * 4) * 1024);
#pragma unroll 1
        for (int tb = 0; tb < CH / 16; ++tb) {
            bf16x8 ac[4];
#pragma unroll
            for (int st = 0; st < 4; ++st) ac[st] = an[st];
            if (!FINAL) { const int tn = tb + 1 < CH / 16 ? tb + 1 : tb;
#pragma unroll
              for (int st = 0; st < 4; ++st) an[st] = ld8(Ua + (size_t)(tn * 16 + st * 4) * 1024); }
            unsigned short uu[4][4];
            if (FINAL) {
#pragma unroll
                for (int cc = 0; cc < 4; ++cc)
#pragma unroll
                    for (int r = 0; r < 4; ++r) uu[cc][r] = U[((size_t)b * T + (size_t)(4 * q + cc) * CH + tb * 16 + 4 * G + r) * 1024 + g * 16 + pl];
            }
#pragma unroll
            for (int st = 0; st < 4; ++st) {
                f32x4 dr[4], di[4];
                __builtin_amdgcn_sched_barrier(0);
#pragma unroll
                for (int j = 0; j < 4; ++j) { dr[j] = MFMA16(ac[st], bfr[j], z4); di[j] = MFMA16(ac[st], bfi[j], z4); }
                __builtin_amdgcn_sched_barrier(0);
                asm volatile("s_nop 15\n\ts_nop 15\n\ts_nop 15" : "+v"(dr[0]), "+v"(dr[1]), "+v"(dr[2]), "+v"(dr[3]), "+v"(di[0]), "+v"(di[1]), "+v"(di[2]), "+v"(di[3]));
                __builtin_amdgcn_sched_barrier(0);
#pragma unroll
                for (int r = 0; r < 4; ++r) {
#pragma unroll
                    for (int j = 0; j < 4; ++j) {
                        x[j] = __builtin_elementwise_fma(ab_r[j], x[j], __builtin_elementwise_fma(ab_i[j], (f32x2s){x[j][1], x[j][0]}, (f32x2s){dr[j][r], di[j][r]}));
                        if (FINAL) { const unsigned w = cvt_pk_bf16(x[j][0], x[j][1]); LAS bf16_t* xp = xt + G * (16 * 136) + (st * 4 + r) * 136 + 16 * j + pl; xp[0] = (bf16_t)(w & 0xffffu); xp[64] = (bf16_t)(w >> 16); }
                    }
                }
                __builtin_amdgcn_sched_barrier(0);
                asm volatile("s_nop 7" : "+v"(x[0]), "+v"(x[1]), "+v"(x[2]), "+v"(x[3]));
            }
            if (FINAL) { const int tn = tb + 1 < CH / 16 ? tb + 1 : tb;
#pragma unroll
              for (int st = 0; st < 4; ++st) an[st] = ld8(Ua + (size_t)(tn * 16 + st * 4) * 1024); }
            if (FINAL) {
                asm volatile("s_waitcnt lgkmcnt(0)" ::: "memory");
#pragma unroll
                for (int cc = 0; cc < 4; ++cc) {
                    f32x4 y = z4;
#pragma unroll
                    for (int ks = 0; ks < 4; ++ks) { const bf16x8 a = *(const LAS bf16x8*)(xt + cc * (16 * 136) + pl * 136 + ks * 32 + G * 8); y = MFMA16(a, cf[ks], y); }
                    __builtin_amdgcn_sched_barrier(0);
                    asm volatile("s_nop 15\n\ts_nop 15" : "+v"(y));
                    __builtin_amdgcn_sched_barrier(0);
                    const size_t rowb = (size_t)b * T + (size_t)(4 * q + cc) * CH + tb * 16 + 4 * G;
#pragma unroll
                    for (int r = 0; r < 4; ++r) { const size_t off = (rowb + r) * 1024 + g * 16 + pl; const float uv = __uint_as_float((unsigned)uu[cc][r] << 16);
                        const unsigned w = cvt_pk_bf16(gelu_tanh(y[r] + dsk * uv), 0.f); Z[off] = (bf16_t)(w & 0xffffu); }
                }
                asm volatile("s_waitcnt lgkmcnt(0)" ::: "memory");
            }
        }
        if (!FINAL) {
#pragma unroll
            for (int j = 0; j < 4; ++j) { float2* Ep = (float2*)E + (((size_t)b * NCH + ch) * 64 + g) * 64 + 16 * j + pl; *Ep = make_float2(x[j][0], x[j][1]); }
        }
        asm volatile("s_waitcnt lgkmcnt(0)" ::: "memory");
    }
}

#define XB_TMO      128
#define XB_XCNT(j)  (256  + 64 * (j))
#define XB_XSUB(j)  (1280 + 64 * (j))
#define XB_XGEN(j)  (2304 + 64 * (j))
#define XB_TOP      3328
#define XB_TOPGEN   3392
#define XCD_BAR_WORDS 3456
#define XB_SPIN_CAP (1u << 18)

__device__ __forceinline__ unsigned xb_ld(unsigned* p)              { return __hip_atomic_load(p, __ATOMIC_RELAXED, __HIP_MEMORY_SCOPE_AGENT); }
__device__ __forceinline__ unsigned xb_add(unsigned* p, unsigned v) { return __hip_atomic_fetch_add(p, v, __ATOMIC_RELAXED, __HIP_MEMORY_SCOPE_AGENT); }
__device__ __forceinline__ unsigned xb_xcc_id() { return (unsigned)__builtin_amdgcn_s_getreg((3 << 11) | 20) & 0xFu; }
#define XB_SPIN(cond, bar) do { unsigned _sp = 0; while (cond) { __builtin_amdgcn_s_sleep(1); \
    if ((++_sp & 255u) == 0u) { if (xb_ld(&(bar)[XB_TMO])) break; if (_sp > XB_SPIN_CAP) { atomicAdd(&(bar)[XB_TMO], 1u); break; } } } } while (0)

struct XcdBarrier {
    unsigned* bar; unsigned x;
    volatile LAS unsigned* st;
};

__device__ __forceinline__ XcdBarrier xcd_barrier_post(unsigned* bar, volatile LAS unsigned* st) {
    XcdBarrier b; b.bar = bar; b.x = xb_xcc_id(); b.st = st;
    if (threadIdx.x == 0) (void)xb_add(&bar[XB_XCNT(b.x)], 1u);
    return b;
}
__device__ __forceinline__ void xcd_barrier_complete(unsigned* bar, unsigned x, unsigned& nloc, unsigned& nx) {
    const unsigned G = gridDim.x * gridDim.y * gridDim.z;
    unsigned sum, cnt, mine, sp = 0u;
    for (;;) {
        sum = 0u; cnt = 0u; mine = 0u;
#pragma unroll
        for (unsigned j = 0; j < 16; ++j) { const unsigned c = xb_ld(&bar[XB_XCNT(j)]); sum += c; cnt += (c > 0u) ? 1u : 0u; mine = (j == x) ? c : mine; }
        if (sum == G) break;
        __builtin_amdgcn_s_sleep(1);
        if ((++sp & 255u) == 0u) { if (xb_ld(&bar[XB_TMO])) break; if (sp > XB_SPIN_CAP) { atomicAdd(&bar[XB_TMO], 1u); break; } }
    }
    nloc = mine > 0u ? mine : 1u; nx = cnt > 0u ? cnt : 1u;
}

__device__ __forceinline__ void xcd_barrier(const XcdBarrier& b) {
    asm volatile("s_waitcnt vmcnt(0)" ::: "memory");
    __syncthreads();
    if (threadIdx.x == 0) {
        unsigned* bar = b.bar;
        __builtin_amdgcn_s_waitcnt(0);
        unsigned nloc = b.st[0], nx = b.st[1];
        if (nloc == 0u) { xcd_barrier_complete(bar, b.x, nloc, nx); b.st[0] = nloc; b.st[1] = nx; }
        const unsigned old = xb_add(&bar[XB_XSUB(b.x)], 1u);
        const unsigned gen = old / nloc;
        if (old + 1u == (gen + 1u) * nloc) {
            __builtin_amdgcn_fence(__ATOMIC_RELEASE, "agent");
            asm volatile("s_waitcnt vmcnt(0)" ::: "memory");
            const unsigned og = xb_add(&bar[XB_TOP], 1u);
            const unsigned tg = og / nx;
            if (og + 1u == (tg + 1u) * nx) xb_add(&bar[XB_TOPGEN], 1u);
            else XB_SPIN(xb_ld(&bar[XB_TOPGEN]) == tg, bar);
            __builtin_amdgcn_fence(__ATOMIC_ACQUIRE, "agent");
            xb_add(&bar[XB_XGEN(b.x)], 1u);
            asm volatile("s_waitcnt vmcnt(0)" ::: "memory");
        } else {
            XB_SPIN(xb_ld(&bar[XB_XGEN(b.x)]) == gen, bar);
            __builtin_amdgcn_fence(__ATOMIC_ACQUIRE, "agent");
            asm volatile("s_waitcnt vmcnt(0)" ::: "memory");
        }
    }
    __syncthreads();
}

enum { K_PREP = 0, K_NORM, K_GEMM, K_CMP2, K_ATTN, K_SCANA, K_SCANC };
constexpr int NPHASES = 27;
struct PhaseDesc { int kind, L, i; bool side; int gG, gc; };
__device__ __forceinline__ void decode_phase(KPtr p, int ph, PhaseDesc& Dd, pg8::Gemm& g, pg8::Epi& E) {
    unsigned char* ws = p->ws; unsigned char* R = ws + WS_R; bf16_t* XN = (bf16_t*)(ws + WS_XN);
        int kind = K_PREP, L = 0, sub = 0;
        if (ph > 0) { const int q = ph - 1, pair = q / 13, r = q % 13; if (r < 7) { L = 2 * pair; sub = r; } else { L = 2 * pair + 1; sub = r - 7; } }
        const int i = L >> 1; const bool nsa = (L & 1) == 0;
        g = pg8::Gemm{nullptr, nullptr, M, 0, D, D}; E = pg8::Epi{}; bool side = false; int gG = gridDim.x, gc = blockIdx.x;
        const float* xcur = (L == 0) ? p->in[I_X] : p->out;
        unsigned long long* SS = (unsigned long long*)(ws + WS_SS);
        if (ph > 0) {
            const int fsub = nsa ? sub - 5 : sub - 4;
            if (fsub >= 0) {
                if (fsub == 0) { kind = K_GEMM; g.A = XN; g.Bt = (const bf16_t*)(ws + WS_WGU + L * 11 * MiB); g.N = 2 * FF; g.K = D; g.lda = D; E.mode = pg8::EPI_SWIGLU; E.o0 = (bf16_t*)(R + R_H); E.ldo = FF; E.ss_in = SS + (size_t)(2 * L + 1) * M; }
                else { kind = K_GEMM; g.A = (const bf16_t*)(R + R_H); g.Bt = (const bf16_t*)(ws + WS_WDN + L * 6 * MiB); g.N = D; g.K = FF; g.lda = FF; E.mode = pg8::EPI_RESID; E.xn_out = XN;
                    if (L < 3) E.ss_out = SS + (size_t)(2 * L + 2) * M; else E.xdst = p->out; }
            } else if (nsa) {
                if (sub == 0) { kind = K_GEMM; g.A = XN; g.Bt = (const bf16_t*)(ws + WS_WIN + i * 6 * MiB); g.N = PROJ_PAD; E.mode = pg8::EPI_PROJ; E.o0 = (bf16_t*)(R + R_Q); E.kv = (bf16_t*)(R + R_KVR); E.kvstride = KV_ELEMS; E.gates = (float*)(R + R_GATES); E.ss_in = SS + (size_t)(2 * L) * M; }
                else if (sub == 1) { kind = K_GEMM; side = true; const int kv = (blockIdx.x >> 5) & 1;
                    g.A = (const bf16_t*)(R + R_KVR) + (size_t)kv * KV_ELEMS; g.Bt = (const bf16_t*)(ws + WS_WC1 + (i * 2 + kv) * MiB); g.M = 8192; g.N = 256; g.K = 2048; g.lda = 1024;
                    E.mode = pg8::EPI_CMP1; E.o0 = (bf16_t*)(R + R_HID) + (size_t)kv * 8192 * 256; E.ldo = 256; E.bias = (const float*)(ws + WS_B1P) + (i * 2 + kv) * 256; gG = 32; gc = blockIdx.x & 31; }
                else if (sub == 2) kind = K_CMP2;
                else if (sub == 3) kind = K_ATTN;
                else { kind = K_GEMM; g.A = (const bf16_t*)(R + R_O); g.Bt = (const bf16_t*)(ws + WS_WOUT + i * 2 * MiB); g.N = D; E.mode = pg8::EPI_RESID; E.ss_out = SS + (size_t)(2 * L + 1) * M; E.xn_out = XN; }
            } else {
                if (sub == 0) { kind = K_GEMM; g.A = XN; g.Bt = (const bf16_t*)(ws + WS_WS5IN + i * 2 * MiB); g.N = D; E.mode = pg8::EPI_PLAIN; E.o0 = (bf16_t*)(R + R_U); E.ldo = D; E.ss_in = SS + (size_t)(2 * L) * M; }
                else if (sub == 1) kind = K_SCANA;
                else if (sub == 2) kind = K_SCANC;
                else { kind = K_GEMM; g.A = (const bf16_t*)(R + R_Z); g.Bt = (const bf16_t*)(ws + WS_WGLU + i * 4 * MiB); g.N = 2 * D; E.mode = pg8::EPI_GLU; E.ss_out = SS + (size_t)(2 * L + 1) * M; E.xn_out = XN; }
            }
        }
    Dd.kind = kind; Dd.L = L; Dd.i = i; Dd.side = side; Dd.gG = gG; Dd.gc = gc;
}
struct LazyEpi {
    static constexpr bool PERM = false, AFTER_DRAIN = false;
    KPtr p; int ph;
    __device__ __forceinline__ void operator()(const f32x4 (&acc)[2][2][4][2], const pg8::Unit& u, int wr, int wc, int fr, int fq) const {
        KPtr pp = p; int phh = ph; asm volatile("" : "+s"(pp), "+s"(phh));
        PhaseDesc Dd; pg8::Gemm g; pg8::Epi E; decode_phase(pp, phh, Dd, g, E);
        E(acc, u, wr, wc, fr, fq);
    }
};
__global__ void __launch_bounds__(NWAVES * 64, 2) fwd_kernel(Params pv) {
    KPtr p = (KPtr)__builtin_amdgcn_kernarg_segment_ptr();
    extern __shared__ __attribute__((aligned(16))) unsigned char lds_raw[];
    LAS unsigned char* lds = (LAS unsigned char*)lds_raw;
        const int ph_lo = p->ph_lo, ph_hi = p->ph_hi;
    volatile LAS unsigned* bst = (volatile LAS unsigned*)(lds + LDS_BYTES - 16);
    if (threadIdx.x == 0) { bst[0] = 0u; bst[1] = 0u; }
    __syncthreads();
    (void)xcd_barrier_post((unsigned*)(p->ws + WS_BAR), bst);
#ifndef PROBE_DUPS
#define PROBE_DUPS
#define PROBE_NDUP 0
#endif
    for (int pe = ph_lo; pe < ph_hi; ++pe) {
        int ph = pe; { const int dups_[] = {PROBE_DUPS -1}; for (int k_ = 0; k_ < PROBE_NDUP; ++k_) if (ph > dups_[k_]) --ph; }
        asm volatile("" : "+s"(p));
        int tid = threadIdx.x; asm volatile("" : "+v"(tid)); const int lane = tid & 63, wave = __builtin_amdgcn_readfirstlane(tid >> 6);
        PhaseDesc Dd; pg8::Gemm g; { pg8::Epi Eunused; decode_phase(p, ph, Dd, g, Eunused); }
        const int kind = Dd.kind, i = Dd.i; const bool side = Dd.side; const int gG = Dd.gG, gc = Dd.gc;
        if (kind == K_PREP) prep_phase(p, lds, wave, lane);
        else if (kind == K_GEMM) {
            if (side && blockIdx.x >= 64) side_phase(p, i, (blockIdx.x - 64) * NWAVES + wave, (gridDim.x - 64) * NWAVES, lds, wave, lane);
            else { pg8::StaticOrder S; S.init(g.M, g.N, gG, gc); LazyEpi LE{p, ph}; pg8::gemm_phase<LazyEpi, pg8::StaticOrder, true, true>(lds, g, S, LE); }
        }
        else if (kind == K_CMP2) cmp2_phase(p, i, wave, lane);
        else if (kind == K_ATTN) attn_phase(p, i, lds, wave, lane);
        else if (kind == K_SCANA) scan_phase<false>(p, i, lds, wave, lane);
        else scan_phase<true>(p, i, lds, wave, lane);
        if (pe + 1 < ph_hi) { asm volatile("s_waitcnt vmcnt(0) lgkmcnt(0)" ::: "memory"); if (ph_hi > 100000) cg::this_grid().sync();   { XcdBarrier gb_; gb_.bar = (unsigned*)(p->ws + WS_BAR); gb_.x = xb_xcc_id(); gb_.st = (volatile LAS unsigned*)(lds + LDS_BYTES - 16); xcd_barrier(gb_); } }
    }
}

#ifndef MK_PER_PHASE
#define MK_PER_PHASE 0
#endif
extern "C" void kernel_launch(void* const* d_in, const int* in_sizes, int n_in, void* d_out, int out_size, void* d_ws, size_t ws_size, hipStream_t stream) {
    static int grid = 0;
    if (grid == 0) {
        if (n_in != 25 || out_size != M * D || ws_size < WS_END) { fprintf(stderr, "kernel_launch: unexpected shapes (n_in %d out %d ws %zu)\n", n_in, out_size, ws_size); grid = -1; return; }
        if (hipFuncSetAttribute((const void*)fwd_kernel, hipFuncAttributeMaxDynamicSharedMemorySize, LDS_BYTES) != hipSuccess) { fprintf(stderr, "kernel_launch: hipFuncSetAttribute failed\n"); grid = -1; return; }
        int dev = 0, cus = 0, per_cu = 0;
        hipGetDevice(&dev); hipDeviceGetAttribute(&cus, hipDeviceAttributeMultiprocessorCount, dev);
        hipOccupancyMaxActiveBlocksPerMultiprocessor(&per_cu, (const void*)fwd_kernel, NWAVES * 64, LDS_BYTES);
        (void)hipGetLastError();
        if (per_cu < 1) { fprintf(stderr, "kernel_launch: occupancy query says %d blocks per CU\n", per_cu); per_cu = 1; }
        grid = cus;
        if (grid > 256) grid = 256;
    }
    if (grid < 0) return;
    if (hipMemsetAsync((char*)d_ws + WS_BAR, 0, 16384 + 16 * 256, stream) != hipSuccess) { fprintf(stderr, "kernel_launch: hipMemsetAsync failed\n"); return; }
    Params p{};
    for (int k = 0; k < 25; ++k) p.in[k] = (const float*)d_in[k];
    p.out = (float*)d_out; p.ws = (unsigned char*)d_ws;
#if MK_PER_PHASE
    for (int ph = 0; ph < NPHASES; ++ph) { p.ph_lo = ph; p.ph_hi = ph + 1; hipLaunchKernelGGL(fwd_kernel, dim3(grid), dim3(NWAVES * 64), LDS_BYTES, stream, p); }
#else
    p.ph_lo = 0; p.ph_hi = NPHASES + PROBE_NDUP;
    void* args[] = {&p};
    hipError_t e = hipLaunchCooperativeKernel((const void*)fwd_kernel, dim3(grid), dim3(NWAVES * 64), args, LDS_BYTES, stream);
    if (e != hipSuccess) fprintf(stderr, "cooperative launch failed: %s (grid %d)\n", hipGetErrorString(e), grid);
#endif
}
```

```cpp
#include <hip/hip_runtime.h>
#include <hip/hip_cooperative_groups.h>
#include <cstdio>
#include <cstdint>
namespace cg = cooperative_groups;

namespace pg8 {
#define PG8_LAS __attribute__((address_space(3)))
typedef unsigned short bf16_t;
typedef short bf16x8 __attribute__((ext_vector_type(8)));
typedef float f32x4 __attribute__((ext_vector_type(4)));
typedef unsigned u32x4 __attribute__((ext_vector_type(4)));
constexpr int BM = 256, BK = 64, HALF = 128, HTB = HALF * BK * 2  , STAGE_BYTES = 8 * HTB, NXCD = 8, WGM = 8;

__host__ __device__ __forceinline__ int lds_byte(int r, int c) { const int st = (r >> 4) * 2 + (c >> 5), rr = r & 15, cc = c & 31, ob = rr * 64 + cc * 2; return st * 1024 + (ob ^ (((ob >> 9) & 1) << 5)); }
__host__ __device__ __forceinline__ void stage_rc(int b, int& R, int& C) { const int st = b / 1024, sb = b % 1024, swz = sb ^ (((sb >> 9) & 1) << 5); R = (st >> 1) * 16 + swz / 64; C = (st & 1) * 32 + (swz % 64) / 2; }
__host__ __device__ __forceinline__ int perm32(int rho) { const int n = rho >> 4, i = rho & 15; return 8 * (i >> 2) + 4 * n + (i & 3); }

struct Unit { int pm, pn; };
struct Gemm { const bf16_t* A; const bf16_t* Bt; int M, N, K, lda; };

struct StaticOrder {
    int nM, nN, nwg, G, c;
    __host__ __device__ void init(int M, int N, int G_, int c_) { nM = M / BM; nN = N / BM; nwg = nM * nN; G = G_; c = c_; }
    __host__ __device__ bool next(int i, Unit& u) const {
        const long L = (long)i * G + c; if (L >= nwg) return false;
        int wgid = (int)L; { const int q = nwg / NXCD, r = nwg % NXCD, xcd = wgid % NXCD, off = wgid / NXCD; wgid = (xcd < r ? xcd * (q + 1) : r * (q + 1) + (xcd - r) * q) + off; }
        const int nig = WGM * nN, gid = wgid / nig, fm = gid * WGM, gsz = (nM - fm) < WGM ? (nM - fm) : WGM;
        u.pm = fm + ((wgid % nig) % gsz); u.pn = (wgid % nig) / gsz; return true;
    }
    __device__ __forceinline__ void a_ready(const Unit&) const {}
    __device__ __forceinline__ void done(const Unit&) const {}
};


typedef unsigned u32x2 __attribute__((ext_vector_type(2)));
__device__ __forceinline__ unsigned cvt_pk_bf16(float lo, float hi) { unsigned r; asm("v_cvt_pk_bf16_f32 %0, %1, %2" : "=v"(r) : "v"(lo), "v"(hi)); return r; }
__device__ __forceinline__ float fast_sigmoid(float x) { return __builtin_amdgcn_rcpf(1.0f + __expf(-x)); }
__device__ __forceinline__ float gelu_tanh(float x) { const float u = 1.5957691216f * (x + 0.044715f * x * x * x); return x * __builtin_amdgcn_rcpf(1.0f + __expf(-u)); }
enum { EPI_PROJ = 0, EPI_CMP1 = 1, EPI_RESID = 2, EPI_SWIGLU = 3, EPI_PLAIN = 4, EPI_GLU = 5 };
struct Epi {
    static constexpr bool PERM = false, AFTER_DRAIN = false;
    int mode; int ldo;
    const float* xsrc; float* xdst;
    bf16_t* o0;
    bf16_t* kv; size_t kvstride;
    float* gates;
    const float* bias;
    const unsigned long long* ss_in;
    unsigned long long* ss_out; bf16_t* xn_out;
    __device__ __forceinline__ float rowscale(int row) const { return ss_in ? 1.0f / sqrtf((float)ss_in[row] * (1.0f / (1024.0f * 16777216.0f)) + 1e-6f) : 1.0f; }
    __device__ __forceinline__ void operator()(const f32x4 (&acc)[2][2][4][2], const Unit& u, int wr, int wc, int fr, int fq) const {
        const int row0 = u.pm * BM + wr * 64 + fr;
        const int colw = wc * 32 + fq * 4;
        if (mode == EPI_PROJ) {
            if (u.pn < 4) {
#pragma unroll
                for (int ai = 0; ai < 2; ++ai)
#pragma unroll
                    for (int m = 0; m < 4; ++m) { bf16_t* rp = o0 + (size_t)(row0 + ai * HALF + m * 16) * 1024 + u.pn * 256 + colw; const float rs = rowscale(row0 + ai * HALF + m * 16);
#pragma unroll
                        for (int bj = 0; bj < 2; ++bj)
#pragma unroll
                            for (int n = 0; n < 2; ++n) { const f32x4 v = acc[ai][bj][m][n] * rs; u32x2 w; w.x = cvt_pk_bf16(v[0], v[1]); w.y = cvt_pk_bf16(v[2], v[3]); *(u32x2*)(rp + bj * HALF + n * 16) = w; } }
            } else if (u.pn < 10) {
                bf16_t* base = kv + (size_t)(u.pn - 4) * kvstride;
#pragma unroll
                for (int ai = 0; ai < 2; ++ai)
#pragma unroll
                    for (int m = 0; m < 4; ++m) { const int row = row0 + ai * HALF + m * 16; const int b = row >> 14, t = row & 16383; const float rs = rowscale(row);
#pragma unroll
                        for (int bj = 0; bj < 2; ++bj)
#pragma unroll
                            for (int n = 0; n < 2; ++n) { const int col = bj * HALF + n * 16 + colw; const int g = col >> 6, d = col & 63;
                                const f32x4 v = acc[ai][bj][m][n] * rs; u32x2 w; w.x = cvt_pk_bf16(v[0], v[1]); w.y = cvt_pk_bf16(v[2], v[3]);
                                *(u32x2*)(base + ((size_t)((b * 4 + g) * 16384 + t)) * 64 + d) = w; } }
            } else {
#pragma unroll
                for (int ai = 0; ai < 2; ++ai)
#pragma unroll
                    for (int m = 0; m < 4; ++m) { const int row = row0 + ai * HALF + m * 16; const float rs = rowscale(row);
#pragma unroll
                        for (int n = 0; n < 2; ++n) { const int col = n * 16 + colw;
                            if (col < 48) { const f32x4 v = acc[ai][0][m][n] * rs; f32x4 o; o[0] = fast_sigmoid(v[0]); o[1] = fast_sigmoid(v[1]); o[2] = fast_sigmoid(v[2]); o[3] = fast_sigmoid(v[3]);
                                *(f32x4*)(gates + (size_t)row * 48 + col) = o; } } }
            }
        } else if (mode == EPI_CMP1 || mode == EPI_PLAIN) {
#pragma unroll
            for (int bj = 0; bj < 2; ++bj)
#pragma unroll
                for (int n = 0; n < 2; ++n) { const int col = u.pn * BM + bj * HALF + n * 16 + colw;
                    f32x4 bv = (f32x4){0.f, 0.f, 0.f, 0.f}; if (mode == EPI_CMP1) bv = *(const f32x4*)(bias + col);
#pragma unroll
                    for (int ai = 0; ai < 2; ++ai)
#pragma unroll
                        for (int m = 0; m < 4; ++m) { f32x4 v = acc[ai][bj][m][n] * rowscale(row0 + ai * HALF + m * 16) + bv;
                            if (mode == EPI_CMP1) { v[0] = gelu_tanh(v[0]); v[1] = gelu_tanh(v[1]); v[2] = gelu_tanh(v[2]); v[3] = gelu_tanh(v[3]); }
                            u32x2 w; w.x = cvt_pk_bf16(v[0], v[1]); w.y = cvt_pk_bf16(v[2], v[3]);
                            *(u32x2*)(o0 + (size_t)(row0 + ai * HALF + m * 16) * ldo + col) = w; } }
        } else if (mode == EPI_RESID) {
#pragma unroll
            for (int ai = 0; ai < 2; ++ai)
#pragma unroll
                for (int m = 0; m < 4; ++m) { const size_t off = (size_t)(row0 + ai * HALF + m * 16) * 1024 + u.pn * BM + colw; float sq = 0.f;
#pragma unroll
                    for (int bj = 0; bj < 2; ++bj)
#pragma unroll
                        for (int n = 0; n < 2; ++n) { const u32x2 xb = *(const u32x2*)(xn_out + off + bj * HALF + n * 16); const f32x4 bs = (f32x4){__uint_as_float(xb.x << 16), __uint_as_float(xb.x & 0xffff0000u), __uint_as_float(xb.y << 16), __uint_as_float(xb.y & 0xffff0000u)};
                            const f32x4 o = bs + acc[ai][bj][m][n]; if (xdst) *(f32x4*)(xdst + off + bj * HALF + n * 16) = o;
                            if (ss_out) { u32x2 w; w.x = cvt_pk_bf16(o[0], o[1]); w.y = cvt_pk_bf16(o[2], o[3]); *(u32x2*)(xn_out + off + bj * HALF + n * 16) = w; sq += (o[0] * o[0] + o[1] * o[1]) + (o[2] * o[2] + o[3] * o[3]); } }
                    if (ss_out) { sq += __shfl_xor(sq, 16); sq += __shfl_xor(sq, 32); if (fq == 0) atomicAdd(ss_out + row0 + ai * HALF + m * 16, (unsigned long long)(sq * 16777216.0f)); } }
        } else if (mode == EPI_SWIGLU) {
#pragma unroll
            for (int ai = 0; ai < 2; ++ai)
#pragma unroll
                for (int m = 0; m < 4; ++m) { bf16_t* rp = o0 + (size_t)(row0 + ai * HALF + m * 16) * ldo + u.pn * HALF + colw; const float rs = rowscale(row0 + ai * HALF + m * 16);
#pragma unroll
                    for (int n = 0; n < 2; ++n) { const f32x4 a = acc[ai][0][m][n] * rs, b = acc[ai][1][m][n] * rs; f32x4 h;
#pragma unroll
                        for (int e = 0; e < 4; ++e) h[e] = a[e] * fast_sigmoid(a[e]) * b[e];
                        u32x2 w; w.x = cvt_pk_bf16(h[0], h[1]); w.y = cvt_pk_bf16(h[2], h[3]); *(u32x2*)(rp + n * 16) = w; } }
        } else {
#pragma unroll
            for (int ai = 0; ai < 2; ++ai)
#pragma unroll
                for (int m = 0; m < 4; ++m) { const size_t off = (size_t)(row0 + ai * HALF + m * 16) * 1024 + u.pn * HALF + colw; float sq = 0.f;
#pragma unroll
                    for (int n = 0; n < 2; ++n) { const f32x4 a = acc[ai][0][m][n], b = acc[ai][1][m][n]; const u32x2 xb = *(const u32x2*)(xn_out + off + n * 16);
                        f32x4 o = (f32x4){__uint_as_float(xb.x << 16), __uint_as_float(xb.x & 0xffff0000u), __uint_as_float(xb.y << 16), __uint_as_float(xb.y & 0xffff0000u)};
#pragma unroll
                        for (int e = 0; e < 4; ++e) o[e] += a[e] * fast_sigmoid(b[e]);
                        if (ss_out) { u32x2 w; w.x = cvt_pk_bf16(o[0], o[1]); w.y = cvt_pk_bf16(o[2], o[3]); *(u32x2*)(xn_out + off + n * 16) = w; sq += (o[0] * o[0] + o[1] * o[1]) + (o[2] * o[2] + o[3] * o[3]); } }
                    if (ss_out) { sq += __shfl_xor(sq, 16); sq += __shfl_xor(sq, 32); if (fq == 0) atomicAdd(ss_out + row0 + ai * HALF + m * 16, (unsigned long long)(sq * 16777216.0f)); } }
        }
    }
};

template <class Epi, class Sched, bool ALIGN_EPI = false, bool SP2 = false>
__device__ __forceinline__ void gemm_phase(PG8_LAS unsigned char* lds, const Gemm g, const Sched& S, const Epi& E) {
    int tid_ = threadIdx.x; asm volatile("" : "+v"(tid_)); const int tid = tid_, wid = __builtin_amdgcn_readfirstlane(tid >> 6), lane = tid & 63, wr = wid >> 2, wc = wid & 3, fr = lane & 15, fq = lane >> 4;
    const int K = g.K, nt = K / BK;
    unsigned voffA[2], voffB[2];
#pragma unroll
    for (int i = 0; i < 2; ++i) { int R, C; stage_rc(tid * 16 + i * 8192, R, C); const int Rb = Epi::PERM ? ((R & ~31) + perm32(R & 31)) : R;
        voffA[i] = (unsigned)(R * g.lda + C) * 2u; voffB[i] = (unsigned)(Rb * K + C) * 2u; }
    const size_t kstep = (size_t)(BK * 2);
    const size_t hstep = (size_t)HALF * K * 2;
    const size_t tstep = 2 * hstep; const size_t hstepA = (size_t)HALF * g.lda * 2, tstepA = 2 * hstepA;
    const unsigned ldsw = (unsigned)wid * 1024u;
    const int aoff = lds_byte(wr * 64 + fr, fq * 8), boff = lds_byte(wc * 32 + fr, fq * 8);
#define PG8_SA(b, h) (((b) * 2 + (h)) * HTB)
#define PG8_SB(b, h) ((4 + (b) * 2 + (h)) * HTB)
#define PG8_STAGE(bufoff, gbase, voff) do { _Pragma("unroll") for (int _i = 0; _i < 2; ++_i) \
        __builtin_amdgcn_global_load_lds((const unsigned*)((const char*)(gbase) + (voff)[_i]), (PG8_LAS unsigned*)(lds + (bufoff) + ldsw + _i * 8192), 16, 0, 0); } while (0)
#define PG8_LDA(dst, b, h) do { _Pragma("unroll") for (int m = 0; m < 4; ++m) _Pragma("unroll") for (int k = 0; k < 2; ++k) dst[m][k] = *(const PG8_LAS bf16x8*)(lds + PG8_SA(b, h) + aoff + m * 2048 + k * 1024); } while (0)
#define PG8_LDB(dst, b, h) do { _Pragma("unroll") for (int n = 0; n < 2; ++n) _Pragma("unroll") for (int k = 0; k < 2; ++k) dst[n][k] = *(const PG8_LAS bf16x8*)(lds + PG8_SB(b, h) + boff + n * 2048 + k * 1024); } while (0)
#define PG8_MMA(ai, bj, At, Bt) do { __builtin_amdgcn_s_setprio(1); _Pragma("unroll") for (int m = 0; m < 4; ++m) _Pragma("unroll") for (int n = 0; n < 2; ++n) _Pragma("unroll") for (int k = 0; k < 2; ++k) \
        acc[ai][bj][m][n] = __builtin_amdgcn_mfma_f32_16x16x32_bf16(Bt[n][k], At[m][k], acc[ai][bj][m][n], 0, 0, 0); __builtin_amdgcn_s_setprio(0); } while (0)
#define PG8_WAIT_V(n) asm volatile("s_waitcnt vmcnt(" #n ")" ::: "memory")
#define PG8_WAIT_L(n) asm volatile("s_waitcnt lgkmcnt(" #n ")" ::: "memory")
#define PG8_BAR __builtin_amdgcn_s_barrier()
#define PG8_SCHED __builtin_amdgcn_sched_barrier(0)
    Unit cur, nxt; int ui = 0;
    if (!S.next(0, cur)) return;
    f32x4 acc[2][2][4][2];
#pragma unroll
    for (int a = 0; a < 2; ++a)
#pragma unroll
        for (int b = 0; b < 2; ++b)
#pragma unroll
            for (int m = 0; m < 4; ++m)
#pragma unroll
                for (int n = 0; n < 2; ++n) acc[a][b][m][n] = (f32x4){0.f, 0.f, 0.f, 0.f};
    bf16x8 At[4][2], B0[2][2], B1[2][2];
    const char* cA = (const char*)g.A + (size_t)cur.pm * tstepA; const char* cB = (const char*)g.Bt + (size_t)cur.pn * tstep;
    S.a_ready(cur);
    if constexpr (SP2) {
        PG8_STAGE(PG8_SB(0, 0), cB, voffB); PG8_STAGE(PG8_SB(0, 1), cB + hstep, voffB); PG8_STAGE(PG8_SA(0, 0), cA, voffA); PG8_STAGE(PG8_SA(0, 1), cA + hstepA, voffA);
        if (wr == 1) PG8_BAR;
        PG8_WAIT_V(2); PG8_BAR;
        PG8_STAGE(PG8_SB(1, 0), cB + kstep, voffB); PG8_STAGE(PG8_SA(1, 0), cA + kstep, voffA); PG8_STAGE(PG8_SB(1, 1), cB + hstep + kstep, voffB);
        PG8_WAIT_V(6); PG8_BAR;
    } else {
        PG8_STAGE(PG8_SB(0, 0), cB, voffB); PG8_STAGE(PG8_SA(0, 0), cA, voffA); PG8_STAGE(PG8_SB(0, 1), cB + hstep, voffB); PG8_STAGE(PG8_SA(0, 1), cA + hstepA, voffA);
        if (wr == 1) PG8_BAR;
        PG8_WAIT_V(4); PG8_BAR;
        PG8_STAGE(PG8_SB(1, 0), cB + kstep, voffB); PG8_STAGE(PG8_SA(1, 0), cA + kstep, voffA); PG8_STAGE(PG8_SB(1, 1), cB + hstep + kstep, voffB);
        PG8_WAIT_V(6); PG8_BAR;
    }
    for (;;) {
        const bool has_next = S.next(ui + 1, nxt);
        const char* nA = has_next ? (const char*)g.A + (size_t)nxt.pm * tstepA : cA; const char* nB = has_next ? (const char*)g.Bt + (size_t)nxt.pn * tstep : cB;
        for (int t = 0; t < nt; t += 2) {
            const bool last = (t == nt - 2);
            const char* a1 = cA + (size_t)(t + 1) * kstep;
            const char* a2 = last ? nA : cA + (size_t)(t + 2) * kstep; const char* b2 = last ? nB : cB + (size_t)(t + 2) * kstep;
            const char* a3 = a2 + kstep; const char* b3 = b2 + kstep;
            if (last && has_next) S.a_ready(nxt);
            if constexpr (SP2) {
            PG8_LDB(B0, 0, 0); PG8_LDB(B1, 0, 1); PG8_SCHED; PG8_LDA(At, 0, 0); PG8_STAGE(PG8_SA(1, 1), a1 + hstepA, voffA);
            PG8_WAIT_V(8); PG8_WAIT_L(0); PG8_BAR; PG8_MMA(0, 0, At, B0); PG8_MMA(0, 1, At, B1); PG8_BAR; PG8_SCHED;
            PG8_LDA(At, 0, 1); PG8_STAGE(PG8_SB(0, 0), b2, voffB); PG8_STAGE(PG8_SB(0, 1), b2 + hstep, voffB); PG8_STAGE(PG8_SA(0, 0), a2, voffA);
            PG8_WAIT_V(8); PG8_WAIT_L(0); PG8_BAR; PG8_MMA(1, 0, At, B0); PG8_MMA(1, 1, At, B1); PG8_BAR; PG8_SCHED;
            PG8_LDB(B0, 1, 0); PG8_LDB(B1, 1, 1); PG8_SCHED; PG8_LDA(At, 1, 0); PG8_STAGE(PG8_SA(0, 1), a2 + hstepA, voffA);
            PG8_WAIT_V(8); PG8_WAIT_L(0); PG8_BAR; PG8_MMA(0, 0, At, B0); PG8_MMA(0, 1, At, B1); PG8_BAR; PG8_SCHED;
            PG8_LDA(At, 1, 1); PG8_STAGE(PG8_SB(1, 0), b3, voffB); PG8_STAGE(PG8_SB(1, 1), b3 + hstep, voffB); PG8_STAGE(PG8_SA(1, 0), a3, voffA);
            PG8_WAIT_V(8); PG8_WAIT_L(0); PG8_BAR; PG8_MMA(1, 0, At, B0); PG8_MMA(1, 1, At, B1); PG8_BAR; PG8_SCHED;
            } else {
            PG8_LDB(B0, 0, 0); PG8_SCHED; PG8_LDA(At, 0, 0); PG8_STAGE(PG8_SA(1, 1), a1 + hstepA, voffA);
            PG8_WAIT_L(8); PG8_BAR; PG8_WAIT_L(0); PG8_MMA(0, 0, At, B0); PG8_BAR; PG8_SCHED;
            PG8_LDB(B1, 0, 1); PG8_STAGE(PG8_SB(0, 0), b2, voffB);
            PG8_BAR; PG8_WAIT_L(0); PG8_MMA(0, 1, At, B1); PG8_BAR;
            PG8_LDA(At, 0, 1); PG8_STAGE(PG8_SA(0, 0), a2, voffA);
            PG8_BAR; PG8_WAIT_L(0); PG8_MMA(1, 0, At, B0); PG8_BAR; PG8_SCHED;
            PG8_STAGE(PG8_SB(0, 1), b2 + hstep, voffB);
            PG8_WAIT_V(6); PG8_BAR; PG8_MMA(1, 1, At, B1); PG8_BAR;
            PG8_LDB(B0, 1, 0); PG8_SCHED; PG8_LDA(At, 1, 0); PG8_STAGE(PG8_SA(0, 1), a2 + hstepA, voffA);
            PG8_WAIT_L(8); PG8_BAR; PG8_WAIT_L(0); PG8_MMA(0, 0, At, B0); PG8_BAR; PG8_SCHED;
            PG8_LDB(B1, 1, 1); PG8_STAGE(PG8_SB(1, 0), b3, voffB);
            PG8_BAR; PG8_WAIT_L(0); PG8_MMA(0, 1, At, B1); PG8_BAR;
            PG8_LDA(At, 1, 1); PG8_STAGE(PG8_SA(1, 0), a3, voffA);
            PG8_BAR; PG8_WAIT_L(0); PG8_MMA(1, 0, At, B0); PG8_BAR; PG8_SCHED;
            PG8_STAGE(PG8_SB(1, 1), b3 + hstep, voffB);
            PG8_WAIT_V(6); PG8_BAR; PG8_MMA(1, 1, At, B1); PG8_BAR;
            }
        }
        if constexpr (ALIGN_EPI) { if (wr == 0) PG8_BAR; }
        if constexpr (!Epi::AFTER_DRAIN) { E(acc, cur, wr, wc, fr, fq); S.done(cur); }
        if (!has_next) break;
#pragma unroll
        for (int a = 0; a < 2; ++a)
#pragma unroll
            for (int b = 0; b < 2; ++b)
#pragma unroll
                for (int m = 0; m < 4; ++m)
#pragma unroll
                    for (int n = 0; n < 2; ++n) acc[a][b][m][n] = (f32x4){0.f, 0.f, 0.f, 0.f};
        cur = nxt; cA = nA; cB = nB; ++ui;
        if constexpr (ALIGN_EPI) { if (wr == 1) PG8_BAR; }
    }
    PG8_WAIT_V(0);
    if constexpr (!ALIGN_EPI) { if (wr == 0) PG8_BAR; }
    PG8_BAR;
    if constexpr (Epi::AFTER_DRAIN) { E.fused(acc, cur, wr, wc, fr, fq, lds, wid, lane); S.done(cur); }
#undef PG8_SA
#undef PG8_SB
#undef PG8_STAGE
#undef PG8_LDA
#undef PG8_LDB
#undef PG8_MMA
#undef PG8_WAIT_V
#undef PG8_WAIT_L
#undef PG8_BAR
#undef PG8_SCHED
}
}

using pg8::bf16_t; using pg8::bf16x8; using pg8::f32x4; using pg8::u32x4; using pg8::u32x2; using pg8::cvt_pk_bf16; using pg8::fast_sigmoid; using pg8::gelu_tanh;
#define LAS __attribute__((address_space(3)))
constexpr int NWAVES = 8;
constexpr int LDS_BYTES = 147456;
constexpr int T = 16384, M = 32768, D = 1024, FF = 2816, PROJ = 2608, PROJ_PAD = 2816;
constexpr float EPS = 1e-6f;
constexpr size_t MiB = 1u << 20;
constexpr size_t WS_WIN = 0;
constexpr size_t WS_WOUT = 12 * MiB;
constexpr size_t WS_WC1 = 16 * MiB;
constexpr size_t WS_WS5IN = 20 * MiB;
constexpr size_t WS_WGLU = 24 * MiB;
constexpr size_t WS_WGU = 32 * MiB;
constexpr size_t WS_WDN = 76 * MiB;
constexpr size_t WS_B1P = 100 * MiB;
constexpr size_t WS_BAR = 100 * MiB + 65536;
constexpr size_t WS_SS = 101 * MiB;
constexpr size_t WS_XN = 104 * MiB;
constexpr size_t WS_R = 168 * MiB;
constexpr size_t KV_ELEMS = (size_t)8 * T * 64 + 32768;
constexpr size_t R_Q = 0, R_O = 64 * MiB, R_KVR = 128 * MiB;
constexpr size_t R_VST = 226 * MiB, R_VWT = R_VST + KV_ELEMS * 2;
constexpr size_t R_GATES = 260 * MiB, R_HID = 266 * MiB, R_KC = 275 * MiB, R_VCT = 277 * MiB;
constexpr size_t R_U = 0, R_Z = 64 * MiB, R_E = 128 * MiB;
constexpr size_t R_H = 0;
constexpr size_t R_KSF = 280 * MiB, R_KWF = R_KSF + KV_ELEMS * 2;
constexpr size_t WS_END = WS_R + 314 * MiB;
static_assert(R_KWF + KV_ELEMS * 2 <= 314 * MiB, "ws map 2");
static_assert(R_KVR + 6 * KV_ELEMS * 2 <= R_VST && R_VWT + KV_ELEMS * 2 <= R_GATES, "ws map");

struct Params { const float* in[25]; float* out; unsigned char* ws; int ph_lo, ph_hi; };
typedef const __attribute__((address_space(4))) Params* KPtr;
enum { I_X = 0, I_MIXN, I_FFNN, I_NWIN, I_NWOUT, I_QG, I_KG, I_CPOS, I_CW1, I_CB1, I_CW2, I_CB2, I_SWIN, I_SBRE, I_SBIM, I_SCRE, I_SCIM, I_SD, I_SLDT, I_SARE, I_SAIM, I_SWGLU, I_FG, I_FU, I_FD };

__device__ __forceinline__ float bf_lo(unsigned w) { return __uint_as_float(w << 16); }
__device__ __forceinline__ float bf_hi(unsigned w) { return __uint_as_float(w & 0xffff0000u); }
__device__ __forceinline__ float wave_sum(float v) {
#pragma unroll
    for (int o = 1; o < 64; o <<= 1) v += __shfl_xor(v, o);
    return v;
}
__device__ __forceinline__ float red_g(float v) { v += __shfl_xor(v, 16); v += __shfl_xor(v, 32); return v; }
__device__ __forceinline__ unsigned wave_max_u(unsigned v) {
    unsigned w;
    w = (unsigned)__builtin_amdgcn_update_dpp((int)v, (int)v, 0x128, 0xf, 0xf, false); v = w > v ? w : v;
    w = (unsigned)__builtin_amdgcn_update_dpp((int)v, (int)v, 0x124, 0xf, 0xf, false); v = w > v ? w : v;
    w = (unsigned)__builtin_amdgcn_update_dpp((int)v, (int)v, 0x122, 0xf, 0xf, false); v = w > v ? w : v;
    w = (unsigned)__builtin_amdgcn_update_dpp((int)v, (int)v, 0x121, 0xf, 0xf, false); v = w > v ? w : v;
    const unsigned a = (unsigned)__builtin_amdgcn_readlane((int)v, 0), b = (unsigned)__builtin_amdgcn_readlane((int)v, 16), c = (unsigned)__builtin_amdgcn_readlane((int)v, 32), d = (unsigned)__builtin_amdgcn_readlane((int)v, 48);
    const unsigned ab = a > b ? a : b, cd = c > d ? c : d; return ab > cd ? ab : cd;
}
__device__ __forceinline__ bf16x8 pack8(const f32x4& a, const f32x4& b) {
    u32x4 w; w.x = cvt_pk_bf16(a[0], a[1]); w.y = cvt_pk_bf16(a[2], a[3]); w.z = cvt_pk_bf16(b[0], b[1]); w.w = cvt_pk_bf16(b[2], b[3]);
    return __builtin_bit_cast(bf16x8, w);
}
__device__ __forceinline__ bf16x8 ld8(const bf16_t* p) { return *(const bf16x8*)p; }
__device__ __forceinline__ bf16x8 ld4x2(const bf16_t* p0, const bf16_t* p1) { u32x4 w; const u32x2 a = *(const u32x2*)p0, b = *(const u32x2*)p1; w.x = a.x; w.y = a.y; w.z = b.x; w.w = b.y; return __builtin_bit_cast(bf16x8, w); }
#define MFMA16(a, b, c) __builtin_amdgcn_mfma_f32_16x16x32_bf16((a), (b), (c), 0, 0, 0)

struct Job { const float* W; int K, ldw, N, Npad; bf16_t* WT; const float* gain; int map; };
__device__ __forceinline__ void transpose_load(const Job& J, int item, int lane, f32x4 (&v)[8]) {
    const int nblk = J.Npad / 32, kb = item / nblk, nb = item % nblk, k0 = 64 * kb, n0 = 32 * nb;
    const int nn = n0 + 4 * (lane & 7);
#pragma unroll
    for (int r = 0; r < 8; ++r) { const int kk = 8 * r + (lane >> 3); v[r] = (f32x4){0.f, 0.f, 0.f, 0.f}; if (nn < J.N) v[r] = *(const f32x4*)(J.W + (size_t)(k0 + kk) * J.ldw + nn);
        if (J.gain) v[r] = v[r] * J.gain[k0 + kk]; }
}
__device__ __forceinline__ void transpose_store(const Job& J, LAS float* scr, int item, int lane, const f32x4 (&v)[8]) {
    const int nblk = J.Npad / 32, kb = item / nblk, nb = item % nblk, k0 = 64 * kb, n0 = 32 * nb;
#pragma unroll
    for (int r = 0; r < 8; ++r) { const int kk = 8 * r + (lane >> 3); LAS float* sp = scr + kk * 33 + 4 * (lane & 7); sp[0] = v[r][0]; sp[1] = v[r][1]; sp[2] = v[r][2]; sp[3] = v[r][3]; }
    asm volatile("s_waitcnt lgkmcnt(0)" ::: "memory");
    const int c = lane & 7;
#pragma unroll
    for (int j = 0; j < 4; ++j) { const int n = (lane >> 3) + 8 * j; const LAS float* s = scr + (8 * c) * 33 + n;
        u32x4 o; o.x = cvt_pk_bf16(s[0 * 33], s[1 * 33]); o.y = cvt_pk_bf16(s[2 * 33], s[3 * 33]); o.z = cvt_pk_bf16(s[4 * 33], s[5 * 33]); o.w = cvt_pk_bf16(s[6 * 33], s[7 * 33]);
        const int ng = n0 + n; int dr = ng; if (J.map) dr = (ng >> 7) * 256 + (ng & 127) + (J.map == 2 ? 128 : 0);
        *(u32x4*)(J.WT + (size_t)dr * J.K + k0 + 8 * c) = o; }
    asm volatile("s_waitcnt lgkmcnt(0)" ::: "memory");
}
constexpr int NJOBS = 26;
__device__ __forceinline__ void get_job(KPtr p, int j, Job& J) {
    unsigned char* ws = p->ws; J.gain = nullptr; J.map = 0;
    if (j < 8) {
        const int i = j >> 2, s = j & 3;
        if (s == 0) { J.W = p->in[I_NWIN] + (size_t)i * D * PROJ; J.K = D; J.ldw = PROJ; J.N = PROJ; J.Npad = PROJ_PAD; J.WT = (bf16_t*)(ws + WS_WIN + i * 6 * MiB); J.gain = p->in[I_MIXN] + (2 * i) * D; }
        else if (s == 1) { J.W = p->in[I_NWOUT] + (size_t)i * D * D; J.K = D; J.ldw = D; J.N = D; J.Npad = D; J.WT = (bf16_t*)(ws + WS_WOUT + i * 2 * MiB); }
        else { const int kv = s - 2; J.W = p->in[I_CW1] + (size_t)(i * 2 + kv) * 2048 * 256; J.K = 2048; J.ldw = 256; J.N = 256; J.Npad = 256; J.WT = (bf16_t*)(ws + WS_WC1 + (i * 2 + kv) * MiB); }
    } else if (j < 14) {
        const int i = (j - 8) / 3, s = (j - 8) % 3;
        if (s == 0) { J.W = p->in[I_SWIN] + (size_t)i * D * D; J.K = D; J.ldw = D; J.N = D; J.Npad = D; J.WT = (bf16_t*)(ws + WS_WS5IN + i * 2 * MiB); J.gain = p->in[I_MIXN] + (2 * i + 1) * D; }
        else { J.W = p->in[I_SWGLU] + (size_t)i * D * 2048 + (s == 2 ? 1024 : 0); J.K = D; J.ldw = 2048; J.N = 1024; J.Npad = 1024; J.WT = (bf16_t*)(ws + WS_WGLU + i * 4 * MiB); J.map = s; }
    } else {
        const int l = (j - 14) / 3, s = (j - 14) % 3;
        if (s < 2) { J.W = p->in[s == 0 ? I_FG : I_FU] + (size_t)l * D * FF; J.K = D; J.ldw = FF; J.N = FF; J.Npad = FF; J.WT = (bf16_t*)(ws + WS_WGU + l * 11 * MiB); J.gain = p->in[I_FFNN] + l * D; J.map = s + 1; }
        else { J.W = p->in[I_FD] + (size_t)l * FF * D; J.K = FF; J.ldw = D; J.N = D; J.Npad = D; J.WT = (bf16_t*)(ws + WS_WDN + l * 6 * MiB); }
    }
}
__device__ __forceinline__ void prep_phase(KPtr p, LAS unsigned char* lds, int wave, int lane) {
    LAS float* scr = (LAS float*)(lds + wave * 16384);
    const int gw = blockIdx.x * NWAVES + wave, NGW = gridDim.x * NWAVES;
    {
        int j = 0, base = 0; Job J; get_job(p, 0, J); int nitems = (J.K / 64) * (J.Npad / 32);
        int it = gw;
        while (j < NJOBS && it >= base + nitems) { base += nitems; ++j; if (j < NJOBS) { get_job(p, j, J); nitems = (J.K / 64) * (J.Npad / 32); } }
        f32x4 vc[8];
        if (j < NJOBS) transpose_load(J, it - base, lane, vc);
        while (j < NJOBS) {
            const Job Jc = J; const int itc = it - base;
            it += NGW;
            while (j < NJOBS && it >= base + nitems) { base += nitems; ++j; if (j < NJOBS) { get_job(p, j, J); nitems = (J.K / 64) * (J.Npad / 32); } }
            f32x4 vn[8];
            if (j < NJOBS) transpose_load(J, it - base, lane, vn);
            transpose_store(Jc, scr, itc, lane, vc);
#pragma unroll
            for (int r = 0; r < 8; ++r) vc[r] = vn[r];
        }
    }
    { unsigned long long* ss = (unsigned long long*)(p->ws + WS_SS);
      unsigned zz_ = 0u; asm volatile("" : "+v"(zz_));
      for (int e = (gw * 64 + lane) * 2; e < 7 * M; e += NGW * 64 * 2) *(u32x4*)(ss + M + e) = (u32x4){zz_, zz_, zz_, zz_};
      bf16_t* xn = (bf16_t*)(p->ws + WS_XN); const float* x = p->in[I_X];
      for (int m = gw; m < M; m += NGW) {
          const f32x4* xr = (const f32x4*)(x + (size_t)m * D) + lane; u32x2* o = (u32x2*)(xn + (size_t)m * D) + lane; float s = 0.f;
#pragma unroll
          for (int q = 0; q < 4; ++q) { const f32x4 v = xr[64 * q]; s += (v[0] * v[0] + v[1] * v[1]) + (v[2] * v[2] + v[3] * v[3]); u32x2 w; w.x = cvt_pk_bf16(v[0], v[1]); w.y = cvt_pk_bf16(v[2], v[3]); o[64 * q] = w; }
          s = wave_sum(s); if (lane == 0) ss[m] = (unsigned long long)(s * 16777216.0f); } }
    for (int o = gw; o < 1024; o += NGW) {
        const int ik = o >> 8, jj = o & 255;
        const float* pos = p->in[I_CPOS] + (size_t)ik * 2048; const float* w1 = p->in[I_CW1] + (size_t)ik * 2048 * 256;
        float s = 0.f;
        for (int k = lane; k < 2048; k += 64) s += pos[k] * w1[(size_t)k * 256 + jj];
        s = wave_sum(s);
        if (lane == 0) ((float*)(p->ws + WS_B1P))[o] = s + p->in[I_CB1][o];
    }
}

__device__ __forceinline__ void norm_phase(const float* x, bf16_t* xn, int wave, int lane) {
    const int gw = blockIdx.x * NWAVES + wave, NGW = gridDim.x * NWAVES;
    for (int m = gw; m < M; m += NGW) {
        const f32x4* xr = (const f32x4*)(x + (size_t)m * D) + lane;
        f32x4 v[4]; float s = 0.f;
#pragma unroll
        for (int j = 0; j < 4; ++j) { v[j] = xr[64 * j]; s += (v[j][0] * v[j][0] + v[j][1] * v[j][1]) + (v[j][2] * v[j][2] + v[j][3] * v[j][3]); }
        const float r = 1.0f / sqrtf(wave_sum(s) * (1.f / D) + EPS);
        u32x2* o = (u32x2*)(xn + (size_t)m * D) + lane;
#pragma unroll
        for (int j = 0; j < 4; ++j) { u32x2 w; w.x = cvt_pk_bf16(v[j][0] * r, v[j][1] * r); w.y = cvt_pk_bf16(v[j][2] * r, v[j][3] * r); o[64 * j] = w; }
    }
}

__device__ __forceinline__ void side_phase(KPtr p, int i, int sw, int NSW, LAS unsigned char* lds, int wave, int lane) {
    unsigned char* R = p->ws + WS_R;
    bf16_t* Qb = (bf16_t*)(R + R_Q); bf16_t* KVR = (bf16_t*)(R + R_KVR);
    const int NQ = M * 16, NK = 8 * T;
    const int sub = lane & 7;
    for (int it = sw; it < (NQ + 2 * NK) / 8; it += NSW) {
        const int r8 = it * 8 + (lane >> 3);
        bf16_t* ptr; bf16_t* dptr; const float* gain; float sc = 1.f;
        if (r8 < NQ) { ptr = Qb + (size_t)r8 * 64; dptr = ptr + sub * 8; gain = p->in[I_QG] + i * 64; sc = 0.18033688011112042f;     }
        else { const bool isw = r8 >= NQ + NK; const int rk = r8 - NQ - (isw ? NK : 0);
            ptr = KVR + (size_t)(isw ? 4 : 2) * KV_ELEMS + (size_t)rk * 64; gain = p->in[I_KG] + (i * 3 + (isw ? 2 : 1)) * 64;
            dptr = (bf16_t*)(R + (isw ? R_KWF : R_KSF)) + (size_t)(rk >> 4) * 1024 + (sub >> 2) * 512 + (sub & 3) * 128 + (rk & 15) * 8; }
        const u32x4 w = *(const u32x4*)(ptr + sub * 8);
        float v[8] = {bf_lo(w.x), bf_hi(w.x), bf_lo(w.y), bf_hi(w.y), bf_lo(w.z), bf_hi(w.z), bf_lo(w.w), bf_hi(w.w)};
        float ss = 0.f;
#pragma unroll
        for (int e = 0; e < 8; ++e) ss += v[e] * v[e];
        ss += __shfl_xor(ss, 1); ss += __shfl_xor(ss, 2); ss += __shfl_xor(ss, 4);
        const float r = sc / sqrtf(ss * (1.f / 64.f) + EPS);
        const f32x4 g0 = *(const f32x4*)(gain + sub * 8), g1 = *(const f32x4*)(gain + sub * 8 + 4);
        u32x4 o; o.x = cvt_pk_bf16(v[0] * r * g0[0], v[1] * r * g0[1]); o.y = cvt_pk_bf16(v[2] * r * g0[2], v[3] * r * g0[3]);
        o.z = cvt_pk_bf16(v[4] * r * g1[0], v[5] * r * g1[1]); o.w = cvt_pk_bf16(v[6] * r * g1[2], v[7] * r * g1[3]);
        *(u32x4*)dptr = o;
    }
    LAS bf16_t* tile = (LAS bf16_t*)(lds + wave * 16384);
    for (int it = sw; it < 4096; it += NSW) {
        const int ten = it >> 11, bgt = (it >> 8) & 7, tt = it & 255;
        const bf16_t* src = KVR + (size_t)(ten == 0 ? 3 : 5) * KV_ELEMS + ((size_t)bgt * T + tt * 64) * 64;
        bf16_t* dst = (bf16_t*)(R + (ten == 0 ? R_VST : R_VWT)) + ((size_t)bgt * T + tt * 64) * 64;
#pragma unroll
        for (int r = 0; r < 8; ++r) { const int e = r * 64 + lane; const int row = e >> 3, ch = e & 7; const u32x4 w = *(const u32x4*)(src + (size_t)e * 8);
            LAS unsigned* tp = (LAS unsigned*)(tile + row * 66 + ch * 8); tp[0] = w.x; tp[1] = w.y; tp[2] = w.z; tp[3] = w.w; }
        asm volatile("s_waitcnt lgkmcnt(0)" ::: "memory");
#pragma unroll
        for (int r = 0; r < 8; ++r) { const int kg = r >> 2, dt = r & 3, d = 16 * dt + (lane & 15), tb = 32 * kg + 4 * (lane >> 4); unsigned short h[8];
#pragma unroll
            for (int j = 0; j < 8; ++j) h[j] = tile[(tb + (j & 3) + (j >> 2) * 16) * 66 + d];
            u32x4 o; o.x = h[0] | ((unsigned)h[1] << 16); o.y = h[2] | ((unsigned)h[3] << 16); o.z = h[4] | ((unsigned)h[5] << 16); o.w = h[6] | ((unsigned)h[7] << 16);
            *(u32x4*)(dst + r * 512 + lane * 8) = o; }
        asm volatile("s_waitcnt lgkmcnt(0)" ::: "memory");
    }
}

__device__ __forceinline__ void cmp2_phase(KPtr p, int i, int wave, int lane) {
    unsigned char* R = p->ws + WS_R;
    const int gw = blockIdx.x * NWAVES + wave, NGW = gridDim.x * NWAVES;
    const int fr = lane & 15, G = lane >> 4;
    for (int u = gw; u < 1024; u += NGW) {
        const int kv = u >> 9, r0 = (u & 511) * 16;
        const bf16_t* Hid = (const bf16_t*)(R + R_HID) + (size_t)kv * 8192 * 256;
        const float* w2 = p->in[I_CW2] + (size_t)(i * 2 + kv) * 256 * 64; const float* b2 = p->in[I_CB2] + (i * 2 + kv) * 64;
        f32x4 acc[4];
#pragma unroll
        for (int nt = 0; nt < 4; ++nt) acc[nt] = (f32x4){0.f, 0.f, 0.f, 0.f};
#pragma unroll 4
        for (int ks = 0; ks < 8; ++ks) {
            const bf16x8 a = ld8(Hid + (size_t)(r0 + fr) * 256 + ks * 32 + G * 8);
#pragma unroll
            for (int nt = 0; nt < 4; ++nt) { const float* wp = w2 + (size_t)(ks * 32 + G * 8) * 64 + nt * 16 + fr;
                u32x4 w; w.x = cvt_pk_bf16(wp[0], wp[64]); w.y = cvt_pk_bf16(wp[128], wp[192]); w.z = cvt_pk_bf16(wp[256], wp[320]); w.w = cvt_pk_bf16(wp[384], wp[448]);
                acc[nt] = MFMA16(a, __builtin_bit_cast(bf16x8, w), acc[nt]); }
        }
#pragma unroll
        for (int nt = 0; nt < 4; ++nt) { const float bv = b2[nt * 16 + fr]; acc[nt] = acc[nt] + bv; }
        if (kv == 0) {
            bf16_t* KC = (bf16_t*)(R + R_KC); const float* kg = p->in[I_KG] + (i * 3 + 0) * 64;
#pragma unroll
            for (int r = 0; r < 4; ++r) { float ss = 0.f;
#pragma unroll
                for (int nt = 0; nt < 4; ++nt) ss += acc[nt][r] * acc[nt][r];
                ss += __shfl_xor(ss, 1); ss += __shfl_xor(ss, 2); ss += __shfl_xor(ss, 4); ss += __shfl_xor(ss, 8);
                const float rr = 1.0f / sqrtf(ss * (1.f / 64.f) + EPS);
#pragma unroll
                for (int nt = 0; nt < 4; ++nt) { const unsigned w = cvt_pk_bf16(acc[nt][r] * rr * kg[nt * 16 + fr], 0.f); const int n = r0 + 4 * G + r, d = nt * 16 + fr; KC[(size_t)(n >> 4) * 1024 + (d >> 5) * 512 + ((d >> 3) & 3) * 128 + (n & 15) * 8 + (d & 7)] = (bf16_t)(w & 0xffffu); } }
        } else {
            bf16_t* VCT = (bf16_t*)(R + R_VCT); const int rr0 = r0 + 4 * G, bgc = rr0 >> 10, n = rr0 & 1023;
#pragma unroll
            for (int nt = 0; nt < 4; ++nt) { u32x2 w; w.x = cvt_pk_bf16(acc[nt][0], acc[nt][1]); w.y = cvt_pk_bf16(acc[nt][2], acc[nt][3]);
                *(u32x2*)(VCT + (size_t)bgc * 65536 + (size_t)((n >> 5) * 4 + nt) * 512 + (G * 16 + fr) * 8 + ((n >> 4) & 1) * 4) = w; }
        }
    }
}

struct AttnT { const bf16_t *Q, *KC, *VCT, *KS, *VST, *KW, *VWT; const float* gates; bf16_t* O; };
constexpr int OS = 260;
__device__ __forceinline__ bf16x8 ldg8(const char* ub, unsigned off) { return *(const bf16x8*)(ub + off); }
__device__ __forceinline__ float ex2(float x) { return __builtin_amdgcn_exp2f(x); }
__device__ __forceinline__ void attn_unit(const AttnT& A, int bg, int qt, LAS float* wl, int lane) {
    const int fr = lane & 15, G = lane >> 4;
    const int b = bg >> 2, g = bg & 3, t0 = qt * 16;
    LAS unsigned* hm = (LAS unsigned*)(wl + 16 * OS);
    const f32x4 z4 = (f32x4){0.f, 0.f, 0.f, 0.f};
    const unsigned koff = lane * 16;
    const char* Qu = (const char*)(A.Q + ((size_t)b * T + t0) * 1024 + g * 256);
    const char* Gu = (const char*)(A.gates + ((size_t)b * T + t0) * 48 + g * 12);
    char* Ou = (char*)(A.O + ((size_t)b * T + t0) * 1024 + g * 256);
    float il[4] = {0.f, 0.f, 0.f, 0.f};
    const int ntile_c = (qt + 15) >> 4, npair_c = (ntile_c + 1) >> 1;
    const int lim = qt - 1;
    const char* KCb = (const char*)(A.KC + (size_t)bg * 1024 * 64); const char* VCb = (const char*)(A.VCT + (size_t)bg * 64 * 1024);
    if (qt > 0) {
        bf16x8 qf[4][2];
#pragma unroll
        for (int hh = 0; hh < 4; ++hh)
#pragma unroll
            for (int ks = 0; ks < 2; ++ks) qf[hh][ks] = ldg8(Qu, fr * 2048 + hh * 128 + ks * 64 + G * 16);
        float ls[4] = {0.f, 0.f, 0.f, 0.f};
        bf16x8 k0 = ldg8(KCb, koff), k1 = ldg8(KCb + 1024, koff);
        for (int tl = 0; tl < ntile_c; ++tl) {
            const int n0 = tl * 16; const int tn = tl + 1 < ntile_c ? tl + 1 : tl;
            const bf16x8 nk0 = ldg8(KCb + tn * 2048, koff), nk1 = ldg8(KCb + tn * 2048 + 1024, koff);
            if (n0 + 15 < lim) {
#pragma unroll
                for (int hh = 0; hh < 4; ++hh) { f32x4 s = MFMA16(k0, qf[hh][0], z4); s = MFMA16(k1, qf[hh][1], s); ls[hh] += (ex2(s[0]) + ex2(s[1])) + (ex2(s[2]) + ex2(s[3])); }
            } else {
#pragma unroll
                for (int hh = 0; hh < 4; ++hh) { f32x4 s = MFMA16(k0, qf[hh][0], z4); s = MFMA16(k1, qf[hh][1], s);
#pragma unroll
                    for (int r = 0; r < 4; ++r) { const int n = n0 + 4 * G + r; const bool valid = (n < lim) || (fr == 15 && n == lim); ls[hh] += valid ? ex2(s[r]) : 0.f; } }
            }
            k0 = nk0; k1 = nk1;
        }
#pragma unroll
        for (int hh = 0; hh < 4; ++hh) { const float l = red_g(ls[hh]); il[hh] = l > 0.f ? 1.0f / l : 0.f; }
    }
#pragma unroll 1
    for (int hp = 0; hp < 2; ++hp) {
        f32x4 acc[2][4];
#pragma unroll
        for (int hh = 0; hh < 2; ++hh)
#pragma unroll
            for (int dt = 0; dt < 4; ++dt) acc[hh][dt] = z4;
        if (qt > 0) {
            bf16x8 qf[2][2];
#pragma unroll
            for (int hh = 0; hh < 2; ++hh)
#pragma unroll
                for (int ks = 0; ks < 2; ++ks) qf[hh][ks] = ldg8(Qu + hp * 256, fr * 2048 + hh * 128 + ks * 64 + G * 16);
            const float ilp[2] = {hp ? il[2] : il[0], hp ? il[3] : il[1]};
            float carry = 0.f;
            bf16x8 ka0 = ldg8(KCb, koff), ka1 = ldg8(KCb + 1024, koff), kb0 = ldg8(KCb + 2048, koff), kb1 = ldg8(KCb + 3072, koff);
            bf16x8 vfc[4];
#pragma unroll
            for (int dt = 0; dt < 4; ++dt) vfc[dt] = ldg8(VCb + dt * 1024, koff);
            for (int pr = 0; pr < npair_c; ++pr) {
                const int n0 = pr * 32; const int pn = pr + 1 < npair_c ? pr + 1 : pr;
                const bf16x8 na0 = ldg8(KCb + pn * 4096, koff), na1 = ldg8(KCb + pn * 4096 + 1024, koff), nb0 = ldg8(KCb + pn * 4096 + 2048, koff), nb1 = ldg8(KCb + pn * 4096 + 3072, koff);
                bf16x8 nvf[4];
#pragma unroll
                for (int dt = 0; dt < 4; ++dt) nvf[dt] = ldg8(VCb + (pn * 4 + dt) * 1024, koff);
                bf16x8 pf[2]; f32x4 psa = z4, psb = z4;
                const bool fullc = n0 + 31 < lim;
#pragma unroll
                for (int hh = 0; hh < 2; ++hh) { f32x4 sa = MFMA16(ka0, qf[hh][0], z4); sa = MFMA16(ka1, qf[hh][1], sa); f32x4 sb = MFMA16(kb0, qf[hh][0], z4); sb = MFMA16(kb1, qf[hh][1], sb);
                    if (fullc) {
#pragma unroll
                        for (int r = 0; r < 4; ++r) { sa[r] = ex2(sa[r]) * ilp[hh]; sb[r] = ex2(sb[r]) * ilp[hh]; }
                    } else {
#pragma unroll
                        for (int r = 0; r < 4; ++r) { const int n = n0 + 4 * G + r; const bool va = (n < lim) || (fr == 15 && n == lim), vb = (n + 16 < lim) || (fr == 15 && n + 16 == lim);
                            sa[r] = va ? ex2(sa[r]) * ilp[hh] : 0.f; sb[r] = vb ? ex2(sb[r]) * ilp[hh] : 0.f; }
                    }
                    psa = psa + sa; psb = psb + sb; pf[hh] = pack8(sa, sb); }
                {
                    const float ta = psa[3], tb = psb[3];
                    const float upa = __shfl(ta, (lane + 48) & 63), nca = __shfl(ta, 48 + fr), upb = __shfl(tb, (lane + 48) & 63), ncb = __shfl(tb, 48 + fr);
                    const float va = (psa[0] + psa[1]) + (psa[2] + psa[3]) + ((G == 0) ? carry : upa);
                    const float vb = (psb[0] + psb[1]) + (psb[2] + psb[3]) + ((G == 0) ? nca : upb);
                    carry = ncb;
                    LAS float* w0 = wl + fr * OS + pr * 8 + G;
                    if (hp == 0) { w0[0] = va; w0[4] = vb; } else { w0[0] += va; w0[4] += vb; }
                }
#pragma unroll
                for (int dt = 0; dt < 4; ++dt) {
#pragma unroll
                    for (int hh = 0; hh < 2; ++hh) acc[hh][dt] = MFMA16(vfc[dt], pf[hh], acc[hh][dt]); }
                ka0 = na0; ka1 = na1; kb0 = nb0; kb1 = nb1;
#pragma unroll
                for (int dt = 0; dt < 4; ++dt) vfc[dt] = nvf[dt];
            }
        }
#pragma unroll
        for (int hh = 0; hh < 2; ++hh) { const float gc = *(const float*)(Gu + fr * 192 + (hp * 2 + hh) * 12);
#pragma unroll
            for (int dt = 0; dt < 4; ++dt) { const f32x4 o = acc[hh][dt] * gc; u32x2 w; w.x = cvt_pk_bf16(o[0], o[1]); w.y = cvt_pk_bf16(o[2], o[3]);
                *(u32x2*)(Ou + fr * 2048 + ((hp * 2 + hh) * 64 + dt * 16 + G * 4) * 2) = w; } }
    }
    hm[lane] = 0u; hm[64 + lane] = 0u;
    {
        const int cur = t0 >> 6;
        if (lane == 0) {
            __hip_atomic_fetch_or(hm, 0xffffu, __ATOMIC_RELAXED, __HIP_MEMORY_SCOPE_WORKGROUP);
            if (cur >= 1) __hip_atomic_fetch_or(hm + (cur >> 1), 0xffffu << ((cur & 1) * 16), __ATOMIC_RELAXED, __HIP_MEMORY_SCOPE_WORKGROUP);
            if (cur >= 2) __hip_atomic_fetch_or(hm + ((cur - 1) >> 1), 0xffffu << (((cur - 1) & 1) * 16), __ATOMIC_RELAXED, __HIP_MEMORY_SCOPE_WORKGROUP);
        }
        if (cur >= 3) {
            const int nfree = 13;
#pragma unroll 1
            for (int i0 = 0; i0 < 4; ++i0) {
                unsigned key[4][4];
#pragma unroll
                for (int qq = 0; qq < 4; ++qq) { const f32x4 v = *(const LAS f32x4*)(wl + (i0 + 4 * qq) * OS + lane * 4);
#pragma unroll
                    for (int c = 0; c < 4; ++c) { const int s = lane * 4 + c;
                        const unsigned k = (__float_as_uint(fmaxf(v[c], 1e-30f)) & 0xffffff00u) | (unsigned)(255 - s); key[qq][c] = (s >= 1 && s <= cur - 2) ? k : 0u; } }
#pragma unroll 1
                for (int it = 0; it < nfree; ++it) {
                    unsigned mm[4];
#pragma unroll
                    for (int qq = 0; qq < 4; ++qq) { unsigned m = key[qq][0] > key[qq][1] ? key[qq][0] : key[qq][1]; const unsigned m2 = key[qq][2] > key[qq][3] ? key[qq][2] : key[qq][3]; mm[qq] = m > m2 ? m : m2; }
#pragma unroll
                    for (int qq = 0; qq < 4; ++qq) mm[qq] = wave_max_u(mm[qq]);
                    if ((mm[0] | mm[1] | mm[2] | mm[3]) == 0u) break;
#pragma unroll
                    for (int qq = 0; qq < 4; ++qq) {
                        if (mm[qq] != 0u) { const int sidx = 255 - (int)(mm[qq] & 255u);
                            if (lane == 0) __hip_atomic_fetch_or(hm + (sidx >> 1), 1u << ((sidx & 1) * 16 + i0 + 4 * qq), __ATOMIC_RELAXED, __HIP_MEMORY_SCOPE_WORKGROUP);
#pragma unroll
                            for (int c = 0; c < 4; ++c) key[qq][c] = (lane * 4 + c == sidx) ? 0u : key[qq][c]; }
                    }
                }
            }
        }
    }
#pragma unroll 1
    for (int hp = 0; hp < 2; ++hp) {
        bf16x8 qf[2][2];
#pragma unroll
        for (int hh = 0; hh < 2; ++hh)
#pragma unroll
            for (int ks = 0; ks < 2; ++ks) qf[hh][ks] = ldg8(Qu + hp * 256, fr * 2048 + hh * 128 + ks * 64 + G * 16);
        f32x4 acc[2][4];
#pragma unroll
        for (int hh = 0; hh < 2; ++hh)
#pragma unroll
            for (int dt = 0; dt < 4; ++dt) acc[hh][dt] = z4;
        const char* KWb = (const char*)(A.KW + (size_t)bg * T * 64); const char* VWb = (const char*)(A.VWT + (size_t)bg * 64 * T);
        int kstart = (t0 - 528) & ~31; if (kstart < 0) kstart = 0;
        const int ntile = (t0 + 16 - kstart) >> 4, npair = (ntile + 1) >> 1;
        float ls[2] = {0.f, 0.f};
        const int tq = t0 + fr;
        bf16x8 ka0 = ldg8(KWb + kstart * 128, koff), ka1 = ldg8(KWb + kstart * 128 + 1024, koff), kb0 = ldg8(KWb + kstart * 128 + 2048, koff), kb1 = ldg8(KWb + kstart * 128 + 3072, koff);
        bf16x8 vfw[4];
#pragma unroll
        for (int dt = 0; dt < 4; ++dt) vfw[dt] = ldg8(VWb + kstart * 128 + dt * 1024, koff);
        for (int pr = 0; pr < npair; ++pr) {
            const int k0p = kstart + pr * 32; const int k0n = pr + 1 < npair ? k0p + 32 : k0p;
            const bf16x8 na0 = ldg8(KWb + k0n * 128, koff), na1 = ldg8(KWb + k0n * 128 + 1024, koff), nb0 = ldg8(KWb + k0n * 128 + 2048, koff), nb1 = ldg8(KWb + k0n * 128 + 3072, koff);
            bf16x8 nvf[4];
#pragma unroll
            for (int dt = 0; dt < 4; ++dt) nvf[dt] = ldg8(VWb + k0n * 128 + dt * 1024, koff);
            const bool full = (k0p + 31 <= t0) && (t0 + 15 - k0p < 512);
            bf16x8 pf[2];
#pragma unroll
            for (int hh = 0; hh < 2; ++hh) { f32x4 sa = MFMA16(ka0, qf[hh][0], z4); sa = MFMA16(ka1, qf[hh][1], sa); f32x4 sb = MFMA16(kb0, qf[hh][0], z4); sb = MFMA16(kb1, qf[hh][1], sb);
                if (full) {
#pragma unroll
                    for (int r = 0; r < 4; ++r) { sa[r] = ex2(sa[r]); sb[r] = ex2(sb[r]); }
                } else {
#pragma unroll
                    for (int r = 0; r < 4; ++r) { const int kp = k0p + 4 * G + r; const bool va = (kp <= tq && tq - kp < 512), vb = (kp + 16 <= tq && tq - kp - 16 < 512);
                        sa[r] = va ? ex2(sa[r]) : 0.f; sb[r] = vb ? ex2(sb[r]) : 0.f; }
                }
                ls[hh] += ((sa[0] + sa[1]) + (sa[2] + sa[3])) + ((sb[0] + sb[1]) + (sb[2] + sb[3]));
                pf[hh] = pack8(sa, sb); }
#pragma unroll
            for (int dt = 0; dt < 4; ++dt) {
#pragma unroll
                for (int hh = 0; hh < 2; ++hh) acc[hh][dt] = MFMA16(vfw[dt], pf[hh], acc[hh][dt]); }
            ka0 = na0; ka1 = na1; kb0 = nb0; kb1 = nb1;
#pragma unroll
            for (int dt = 0; dt < 4; ++dt) vfw[dt] = nvf[dt];
        }
#pragma unroll
        for (int hh = 0; hh < 2; ++hh) { const float sc = *(const float*)(Gu + fr * 192 + (hp * 2 + hh) * 12 + 8) / red_g(ls[hh]);
#pragma unroll
            for (int dt = 0; dt < 4; ++dt) *(LAS f32x4*)(wl + fr * OS + (hp * 2 + hh) * 64 + dt * 16 + G * 4) = acc[hh][dt] * sc; }
    }
    {
        const char* KSb = (const char*)(A.KS + (size_t)bg * T * 64); const char* VSb = (const char*)(A.VST + (size_t)bg * 64 * T);
        const int cur = t0 >> 6;
        const int cq = fr >> 2, ch = fr & 3;
        bf16x8 qs[4][2];
#pragma unroll
        for (int qg = 0; qg < 4; ++qg)
#pragma unroll
            for (int ks = 0; ks < 2; ++ks) qs[qg][ks] = ldg8(Qu, (4 * qg + cq) * 2048 + ch * 128 + ks * 64 + G * 16);
        f32x4 acc[4][4]; float ls[4] = {0.f, 0.f, 0.f, 0.f};
#pragma unroll
        for (int qg = 0; qg < 4; ++qg)
#pragma unroll
            for (int dt = 0; dt < 4; ++dt) acc[qg][dt] = z4;
        int s = 0; unsigned m = 0xffffu;
#pragma unroll 1
        while (s <= cur) {
            bf16x8 kf[4], kg[4], vf[8];
#pragma unroll
            for (int c = 0; c < 4; ++c) kf[c] = ldg8(KSb + (size_t)s * 8192 + c * 1024, koff);
#pragma unroll
            for (int c = 0; c < 4; ++c) kg[c] = ldg8(KSb + (size_t)s * 8192 + 4096 + c * 1024, koff);
#pragma unroll
            for (int c = 0; c < 8; ++c) vf[c] = ldg8(VSb + (size_t)s * 8192 + c * 1024, koff);
            int sn = s + 1; unsigned mn = 0u;
            while (sn <= cur) { mn = ((unsigned)__builtin_amdgcn_readfirstlane((int)hm[sn >> 1]) >> ((sn & 1) * 16)) & 0xffffu; if (mn) break; ++sn; }
            const bool part = (s == cur);
#pragma unroll
            for (int qg = 0; qg < 4; ++qg) {
                if (((m >> (4 * qg)) & 0xfu) == 0u) continue;
                const bool hit = ((m >> (4 * qg + cq)) & 1u) != 0u;
                const int tq = t0 + 4 * qg + cq;
#pragma unroll
                for (int pq = 0; pq < 2; ++pq) {
                    f32x4 sa = MFMA16(pq ? kg[0] : kf[0], qs[qg][0], z4); sa = MFMA16(pq ? kg[1] : kf[1], qs[qg][1], sa);
                    f32x4 sb = MFMA16(pq ? kg[2] : kf[2], qs[qg][0], z4); sb = MFMA16(pq ? kg[3] : kf[3], qs[qg][1], sb);
                    if (part) {
#pragma unroll
                        for (int r = 0; r < 4; ++r) { const int kp = s * 64 + pq * 32 + 4 * G + r; const bool va = hit && kp <= tq, vb = hit && kp + 16 <= tq;
                            sa[r] = va ? ex2(sa[r]) : 0.f; sb[r] = vb ? ex2(sb[r]) : 0.f; }
                    } else {
#pragma unroll
                        for (int r = 0; r < 4; ++r) { sa[r] = hit ? ex2(sa[r]) : 0.f; sb[r] = hit ? ex2(sb[r]) : 0.f; }
                    }
                    ls[qg] += ((sa[0] + sa[1]) + (sa[2] + sa[3])) + ((sb[0] + sb[1]) + (sb[2] + sb[3]));
                    const bf16x8 pf = pack8(sa, sb);
#pragma unroll
                    for (int dt = 0; dt < 4; ++dt) acc[qg][dt] = MFMA16(vf[pq * 4 + dt], pf, acc[qg][dt]);
                }
            }
            s = sn; m = mn;
        }
#pragma unroll
        for (int qg = 0; qg < 4; ++qg) { const float sc = *(const float*)(Gu + (4 * qg + cq) * 192 + ch * 12 + 4) / red_g(ls[qg]);
#pragma unroll
            for (int dt = 0; dt < 4; ++dt) { LAS f32x4* op = (LAS f32x4*)(wl + (4 * qg + cq) * OS + ch * 64 + dt * 16 + G * 4); *op = *op + acc[qg][dt] * sc; } }
    }
    asm volatile("s_waitcnt vmcnt(0)" ::: "memory");
#pragma unroll 4
    for (int q = 0; q < 16; ++q) { const f32x4 v = *(const LAS f32x4*)(wl + q * OS + lane * 4); const u32x2 pw = *(const u32x2*)(Ou + q * 2048 + lane * 8); u32x2 w;
        w.x = cvt_pk_bf16(v[0] + bf_lo(pw.x), v[1] + bf_hi(pw.x)); w.y = cvt_pk_bf16(v[2] + bf_lo(pw.y), v[3] + bf_hi(pw.y));
        *(u32x2*)(Ou + q * 2048 + lane * 8) = w; }
}
__device__ __forceinline__ void attn_phase(KPtr p, int i, LAS unsigned char* lds, int wave, int lane) {
    unsigned char* R = p->ws + WS_R; const bf16_t* KVR = (const bf16_t*)(R + R_KVR);
    AttnT A; A.Q = (const bf16_t*)(R + R_Q); A.KC = (const bf16_t*)(R + R_KC); A.VCT = (const bf16_t*)(R + R_VCT); A.KS = (const bf16_t*)(R + R_KSF); A.VST = (const bf16_t*)(R + R_VST);
    A.KW = (const bf16_t*)(R + R_KWF); A.VWT = (const bf16_t*)(R + R_VWT); A.gates = (const float*)(R + R_GATES); A.O = (bf16_t*)(R + R_O);
    LAS float* wl = (LAS float*)(lds + wave * 17408);
    const bool xa = (gridDim.x & 7) == 0;
    unsigned* cnt = (unsigned*)(p->ws + WS_BAR + 16384) + (size_t)(i * 8 + (xa ? (int)(blockIdx.x & 7) : 0)) * 64;
    const unsigned total = xa ? 1024u : 8192u;
#pragma unroll 1
    for (;;) {
        unsigned idx = 0u; if (lane == 0) idx = atomicAdd(cnt, 1u);
        idx = (unsigned)__builtin_amdgcn_readfirstlane((int)idx);
        if (idx >= total) break;
        int bg, qt;
        if (xa) { bg = blockIdx.x & 7; qt = 1023 - (int)idx; } else { bg = (int)(idx & 7u); qt = 1023 - (int)(idx >> 3); }
        attn_unit(A, bg, qt, wl, lane);
    }
}

constexpr int CH = 128, NCH = T / CH;
typedef float f32x2s __attribute__((ext_vector_type(2)));
template <bool FINAL>
__device__ __forceinline__ void scan_phase(KPtr p, int i, LAS unsigned char* lds, int wave, int lane) {
    unsigned char* R = p->ws + WS_R;
    const bf16_t* U = (const bf16_t*)(R + R_U); bf16_t* Z = (bf16_t*)(R + R_Z); float* E = (float*)(R + R_E);
    LAS bf16_t* xt = (LAS bf16_t*)(lds + wave * 17408);
    const int gw = blockIdx.x * NWAVES + wave, NGW = gridDim.x * NWAVES;
    const int pl = lane & 15, G = lane >> 4;
    const f32x4 z4 = (f32x4){0.f, 0.f, 0.f, 0.f};
#pragma unroll 1
    for (int u = gw, it_ = 0; u < 2 * 32 * 64; u += NGW, ++it_) {
        const int g = u & 63, b = u >> 11; const int q = ((it_ & 1) && (NGW % 2048 == 0)) ? 31 - ((u >> 6) & 31) : ((u >> 6) & 31);
        const int ch = 4 * q + G;
        const float dt = __expf(p->in[I_SLDT][i * 64 + g]);
        f32x2s ab_r[4], ab_i[4]; bf16x8 bfr[4], bfi[4];
#pragma unroll
        for (int j = 0; j < 4; ++j) {
            const int sidx = (i * 64 + g) * 64 + 16 * j + pl;
            const float ar = p->in[I_SARE][sidx], ai = p->in[I_SAIM][sidx];
            const float mag = expf(dt * ar); float sn, cs; sincosf(dt * ai, &sn, &cs);
            const float abr = mag * cs, abi = mag * sn, den = ar * ar + ai * ai;
            const float cr = ((abr - 1.0f) * ar + abi * ai) / den, ci = (abi * ar - (abr - 1.0f) * ai) / den;
            ab_r[j] = (f32x2s){abr, abr}; ab_i[j] = (f32x2s){-abi, abi};
            f32x4 r0, r1, i0, i1;
            { const f32x4* brp = (const f32x4*)(p->in[I_SBRE] + (size_t)sidx * 16 + 8 * (G & 1)); const f32x4* bip = (const f32x4*)(p->in[I_SBIM] + (size_t)sidx * 16 + 8 * (G & 1));
                const f32x4 br0 = brp[0], br1 = brp[1], bi0 = bip[0], bi1 = bip[1]; const float km = (G < 2) ? 1.f : 0.f;
                r0 = (br0 * cr - bi0 * ci) * km; r1 = (br1 * cr - bi1 * ci) * km; i0 = (bi0 * cr + br0 * ci) * km; i1 = (bi1 * cr + br1 * ci) * km; }
            bfr[j] = pack8(r0, r1); bfi[j] = pack8(i0, i1);
        }
        f32x2s x[4] = {(f32x2s){0.f, 0.f}, (f32x2s){0.f, 0.f}, (f32x2s){0.f, 0.f}, (f32x2s){0.f, 0.f}};
        bf16x8 cf[4]; float dsk = 0.f;
        if (FINAL) {
            float pw_r[4], pw_i[4], cr_[4] = {0.f, 0.f, 0.f, 0.f}, ci_[4] = {0.f, 0.f, 0.f, 0.f};
#pragma unroll
            for (int j = 0; j < 4; ++j) { float pr_ = ab_r[j][0], pi_ = ab_i[j][1];
#pragma unroll
                for (int s = 0; s < 7; ++s) { const float nr = pr_ * pr_ - pi_ * pi_, ni = 2.f * pr_ * pi_; pr_ = nr; pi_ = ni; }
                pw_r[j] = pr_; pw_i[j] = pi_; }
            const float2* Ep = (const float2*)E + ((size_t)b * NCH * 64 + g) * 64 + pl;
            int c = 0;
#pragma unroll 1
            for (; c + 8 <= ch; c += 8) { float2 e[8][4];
#pragma unroll
                for (int s = 0; s < 8; ++s)
#pragma unroll
                    for (int j = 0; j < 4; ++j) e[s][j] = Ep[(size_t)(c + s) * 4096 + 16 * j];
#pragma unroll
                for (int s = 0; s < 8; ++s)
#pragma unroll
                    for (int j = 0; j < 4; ++j) { const float nr = pw_r[j] * cr_[j] - pw_i[j] * ci_[j] + e[s][j].x, ni = pw_r[j] * ci_[j] + pw_i[j] * cr_[j] + e[s][j].y; cr_[j] = nr; ci_[j] = ni; } }
#pragma unroll 1
            for (; c < ch; ++c) {
#pragma unroll
                for (int j = 0; j < 4; ++j) { const float2 e = Ep[(size_t)c * 4096 + 16 * j]; const float nr = pw_r[j] * cr_[j] - pw_i[j] * ci_[j] + e.x, ni = pw_r[j] * ci_[j] + pw_i[j] * cr_[j] + e.y; cr_[j] = nr; ci_[j] = ni; } }
#pragma unroll
            for (int j = 0; j < 4; ++j) x[j] = (f32x2s){cr_[j], ci_[j]};
#pragma unroll
            for (int ks = 0; ks < 4; ++ks) { const float* cp = p->in[ks < 2 ? I_SCRE : I_SCIM] + ((size_t)(i * 64 + g) * 16 + pl) * 64 + (ks & 1) * 32 + G * 8; const float sg = ks < 2 ? 1.f : -1.f;
                const f32x4 c0 = *(const f32x4*)cp * sg, c1 = *(const f32x4*)(cp + 4) * sg; cf[ks] = pack8(c0, c1); }
            dsk = p->in[I_SD][i * 1024 + g * 16 + pl];
        }
        const bf16_t* Ua = U + ((size_t)b * T + (size_t)(4 * q + (pl >> 2)) * CH + (pl & 3)) * 1024 + g * 16 + 8 * (G & 1);
        bf16x8 an[4];
#pragma unroll
        for (int st = 0; st < 4; ++st) an[st] = ld8(Ua + (size_t)(st * 4) * 1024);
#pragma unroll 1
        for (int tb = 0; tb < CH / 16; ++tb) {
            bf16x8 ac[4];
#pragma unroll
            for (int st = 0; st < 4; ++st) ac[st] = an[st];
            if (!FINAL) { const int tn = tb + 1 < CH / 16 ? tb + 1 : tb;
#pragma unroll
              for (int st = 0; st < 4; ++st) an[st] = ld8(Ua + (size_t)(tn * 16 + st * 4) * 1024); }
            unsigned short uu[4][4];
            if (FINAL) {
#pragma unroll
                for (int cc = 0; cc < 4; ++cc)
#pragma unroll
                    for (int r = 0; r < 4; ++r) uu[cc][r] = U[((size_t)b * T + (size_t)(4 * q + cc) * CH + tb * 16 + 4 * G + r) * 1024 + g * 16 + pl];
            }
#pragma unroll
            for (int st = 0; st < 4; ++st) {
                f32x4 dr[4], di[4];
                __builtin_amdgcn_sched_barrier(0);
#pragma unroll
                for (int j = 0; j < 4; ++j) { dr[j] = MFMA16(ac[st], bfr[j], z4); di[j] = MFMA16(ac[st], bfi[j], z4); }
                __builtin_amdgcn_sched_barrier(0);
                asm volatile("s_nop 15\n\ts_nop 15\n\ts_nop 15" : "+v"(dr[0]), "+v"(dr[1]), "+v"(dr[2]), "+v"(dr[3]), "+v"(di[0]), "+v"(di[1]), "+v"(di[2]), "+v"(di[3]));
                __builtin_amdgcn_sched_barrier(0);
#pragma unroll
                for (int r = 0; r < 4; ++r) {
#pragma unroll
                    for (int j = 0; j < 4; ++j) {
                        x[j] = __builtin_elementwise_fma(ab_r[j], x[j], __builtin_elementwise_fma(ab_i[j], (f32x2s){x[j][1], x[j][0]}, (f32x2s){dr[j][r], di[j][r]}));
                        if (FINAL) { const unsigned w = cvt_pk_bf16(x[j][0], x[j][1]); LAS bf16_t* xp = xt + G * (16 * 136) + (st * 4 + r) * 136 + 16 * j + pl; xp[0] = (bf16_t)(w & 0xffffu); xp[64] = (bf16_t)(w >> 16); }
                    }
                }
                __builtin_amdgcn_sched_barrier(0);
                asm volatile("s_nop 7" : "+v"(x[0]), "+v"(x[1]), "+v"(x[2]), "+v"(x[3]));
            }
            if (FINAL) { const int tn = tb + 1 < CH / 16 ? tb + 1 : tb;
#pragma unroll
              for (int st = 0; st < 4; ++st) an[st] = ld8(Ua + (size_t)(tn * 16 + st * 4) * 1024); }
            if (FINAL) {
                asm volatile("s_waitcnt lgkmcnt(0)" ::: "memory");
#pragma unroll
                for (int cc = 0; cc < 4; ++cc) {
                    f32x4 y = z4;
#pragma unroll
                    for (int ks = 0; ks < 4; ++ks) { const bf16x8 a = *(const LAS bf16x8*)(xt + cc * (16 * 136) + pl * 136 + ks * 32 + G * 8); y = MFMA16(a, cf[ks], y); }
                    __builtin_amdgcn_sched_barrier(0);
                    asm volatile("s_nop 15\n\ts_nop 15" : "+v"(y));
                    __builtin_amdgcn_sched_barrier(0);
                    const size_t rowb = (size_t)b * T + (size_t)(4 * q + cc) * CH + tb * 16 + 4 * G;
#pragma unroll
                    for (int r = 0; r < 4; ++r) { const size_t off = (rowb + r) * 1024 + g * 16 + pl; const float uv = __uint_as_float((unsigned)uu[cc][r] << 16);
                        const unsigned w = cvt_pk_bf16(gelu_tanh(y[r] + dsk * uv), 0.f); Z[off] = (bf16_t)(w & 0xffffu); }
                }
                asm volatile("s_waitcnt lgkmcnt(0)" ::: "memory");
            }
        }
        if (!FINAL) {
#pragma unroll
            for (int j = 0; j < 4; ++j) { float2* Ep = (float2*)E + (((size_t)b * NCH + ch) * 64 + g) * 64 + 16 * j + pl; *Ep = make_float2(x[j][0], x[j][1]); }
        }
        asm volatile("s_waitcnt lgkmcnt(0)" ::: "memory");
    }
}

#define XB_TMO      128
#define XB_XCNT(j)  (256  + 64 * (j))
#define XB_XSUB(j)  (1280 + 64 * (j))
#define XB_XGEN(j)  (2304 + 64 * (j))
#define XB_TOP      3328
#define XB_TOPGEN   3392
#define XCD_BAR_WORDS 3456
#define XB_SPIN_CAP (1u << 18)

__device__ __forceinline__ unsigned xb_ld(unsigned* p)              { return __hip_atomic_load(p, __ATOMIC_RELAXED, __HIP_MEMORY_SCOPE_AGENT); }
__device__ __forceinline__ unsigned xb_add(unsigned* p, unsigned v) { return __hip_atomic_fetch_add(p, v, __ATOMIC_RELAXED, __HIP_MEMORY_SCOPE_AGENT); }
__device__ __forceinline__ unsigned xb_xcc_id() { return (unsigned)__builtin_amdgcn_s_getreg((3 << 11) | 20) & 0xFu; }
#define XB_SPIN(cond, bar) do { unsigned _sp = 0; while (cond) { __builtin_amdgcn_s_sleep(1); \
    if ((++_sp & 255u) == 0u) { if (xb_ld(&(bar)[XB_TMO])) break; if (_sp > XB_SPIN_CAP) { atomicAdd(&(bar)[XB_TMO], 1u); break; } } } } while (0)

struct XcdBarrier {
    unsigned* bar; unsigned x;
    volatile LAS unsigned* st;
};

__device__ __forceinline__ XcdBarrier xcd_barrier_post(unsigned* bar, volatile LAS unsigned* st) {
    XcdBarrier b; b.bar = bar; b.x = xb_xcc_id(); b.st = st;
    if (threadIdx.x == 0) (void)xb_add(&bar[XB_XCNT(b.x)], 1u);
    return b;
}
__device__ __forceinline__ void xcd_barrier_complete(unsigned* bar, unsigned x, unsigned& nloc, unsigned& nx) {
    const unsigned G = gridDim.x * gridDim.y * gridDim.z;
    unsigned sum, cnt, mine, sp = 0u;
    for (;;) {
        sum = 0u; cnt = 0u; mine = 0u;
#pragma unroll
        for (unsigned j = 0; j < 16; ++j) { const unsigned c = xb_ld(&bar[XB_XCNT(j)]); sum += c; cnt += (c > 0u) ? 1u : 0u; mine = (j == x) ? c : mine; }
        if (sum == G) break;
        __builtin_amdgcn_s_sleep(1);
        if ((++sp & 255u) == 0u) { if (xb_ld(&bar[XB_TMO])) break; if (sp > XB_SPIN_CAP) { atomicAdd(&bar[XB_TMO], 1u); break; } }
    }
    nloc = mine > 0u ? mine : 1u; nx = cnt > 0u ? cnt : 1u;
}

__device__ __forceinline__ void xcd_barrier(const XcdBarrier& b) {
    asm volatile("s_waitcnt vmcnt(0)" ::: "memory");
    __syncthreads();
    if (threadIdx.x == 0) {
        unsigned* bar = b.bar;
        __builtin_amdgcn_s_waitcnt(0);
        unsigned nloc = b.st[0], nx = b.st[1];
        if (nloc == 0u) { xcd_barrier_complete(bar, b.x, nloc, nx); b.st[0] = nloc; b.st[1] = nx; }
        const unsigned old = xb_add(&bar[XB_XSUB(b.x)], 1u);
        const unsigned gen = old / nloc;
        if (old + 1u == (gen + 1u) * nloc) {
            __builtin_amdgcn_fence(__ATOMIC_RELEASE, "agent");
            asm volatile("s_waitcnt vmcnt(0)" ::: "memory");
            const unsigned og = xb_add(&bar[XB_TOP], 1u);
            const unsigned tg = og / nx;
            if (og + 1u == (tg + 1u) * nx) xb_add(&bar[XB_TOPGEN], 1u);
            else XB_SPIN(xb_ld(&bar[XB_TOPGEN]) == tg, bar);
            __builtin_amdgcn_fence(__ATOMIC_ACQUIRE, "agent");
            xb_add(&bar[XB_XGEN(b.x)], 1u);
            asm volatile("s_waitcnt vmcnt(0)" ::: "memory");
        } else {
            XB_SPIN(xb_ld(&bar[XB_XGEN(b.x)]) == gen, bar);
            __builtin_amdgcn_fence(__ATOMIC_ACQUIRE, "agent");
            asm volatile("s_waitcnt vmcnt(0)" ::: "memory");
        }
    }
    __syncthreads();
}

enum { K_PREP = 0, K_NORM, K_GEMM, K_CMP2, K_ATTN, K_SCANA, K_SCANC };
constexpr int NPHASES = 27;
struct PhaseDesc { int kind, L, i; bool side; int gG, gc; };
__device__ __forceinline__ void decode_phase(KPtr p, int ph, PhaseDesc& Dd, pg8::Gemm& g, pg8::Epi& E) {
    unsigned char* ws = p->ws; unsigned char* R = ws + WS_R; bf16_t* XN = (bf16_t*)(ws + WS_XN);
        int kind = K_PREP, L = 0, sub = 0;
        if (ph > 0) { const int q = ph - 1, pair = q / 13, r = q % 13; if (r < 7) { L = 2 * pair; sub = r; } else { L = 2 * pair + 1; sub = r - 7; } }
        const int i = L >> 1; const bool nsa = (L & 1) == 0;
        g = pg8::Gemm{nullptr, nullptr, M, 0, D, D}; E = pg8::Epi{}; bool side = false; int gG = gridDim.x, gc = blockIdx.x;
        const float* xcur = (L == 0) ? p->in[I_X] : p->out;
        unsigned long long* SS = (unsigned long long*)(ws + WS_SS);
        if (ph > 0) {
            const int fsub = nsa ? sub - 5 : sub - 4;
            if (fsub >= 0) {
                if (fsub == 0) { kind = K_GEMM; g.A = XN; g.Bt = (const bf16_t*)(ws + WS_WGU + L * 11 * MiB); g.N = 2 * FF; g.K = D; g.lda = D; E.mode = pg8::EPI_SWIGLU; E.o0 = (bf16_t*)(R + R_H); E.ldo = FF; E.ss_in = SS + (size_t)(2 * L + 1) * M; }
                else { kind = K_GEMM; g.A = (const bf16_t*)(R + R_H); g.Bt = (const bf16_t*)(ws + WS_WDN + L * 6 * MiB); g.N = D; g.K = FF; g.lda = FF; E.mode = pg8::EPI_RESID; E.xn_out = XN;
                    if (L < 3) E.ss_out = SS + (size_t)(2 * L + 2) * M; else E.xdst = p->out; }
            } else if (nsa) {
                if (sub == 0) { kind = K_GEMM; g.A = XN; g.Bt = (const bf16_t*)(ws + WS_WIN + i * 6 * MiB); g.N = PROJ_PAD; E.mode = pg8::EPI_PROJ; E.o0 = (bf16_t*)(R + R_Q); E.kv = (bf16_t*)(R + R_KVR); E.kvstride = KV_ELEMS; E.gates = (float*)(R + R_GATES); E.ss_in = SS + (size_t)(2 * L) * M; }
                else if (sub == 1) { kind = K_GEMM; side = true; const int kv = (blockIdx.x >> 5) & 1;
                    g.A = (const bf16_t*)(R + R_KVR) + (size_t)kv * KV_ELEMS; g.Bt = (const bf16_t*)(ws + WS_WC1 + (i * 2 + kv) * MiB); g.M = 8192; g.N = 256; g.K = 2048; g.lda = 1024;
                    E.mode = pg8::EPI_CMP1; E.o0 = (bf16_t*)(R + R_HID) + (size_t)kv * 8192 * 256; E.ldo = 256; E.bias = (const float*)(ws + WS_B1P) + (i * 2 + kv) * 256; gG = 32; gc = blockIdx.x & 31; }
                else if (sub == 2) kind = K_CMP2;
                else if (sub == 3) kind = K_ATTN;
                else { kind = K_GEMM; g.A = (const bf16_t*)(R + R_O); g.Bt = (const bf16_t*)(ws + WS_WOUT + i * 2 * MiB); g.N = D; E.mode = pg8::EPI_RESID; E.ss_out = SS + (size_t)(2 * L + 1) * M; E.xn_out = XN; }
            } else {
                if (sub == 0) { kind = K_GEMM; g.A = XN; g.Bt = (const bf16_t*)(ws + WS_WS5IN + i * 2 * MiB); g.N = D; E.mode = pg8::EPI_PLAIN; E.o0 = (bf16_t*)(R + R_U); E.ldo = D; E.ss_in = SS + (size_t)(2 * L) * M; }
                else if (sub == 1) kind = K_SCANA;
                else if (sub == 2) kind = K_SCANC;
                else { kind = K_GEMM; g.A = (const bf16_t*)(R + R_Z); g.Bt = (const bf16_t*)(ws + WS_WGLU + i * 4 * MiB); g.N = 2 * D; E.mode = pg8::EPI_GLU; E.ss_out = SS + (size_t)(2 * L + 1) * M; E.xn_out = XN; }
            }
        }
    Dd.kind = kind; Dd.L = L; Dd.i = i; Dd.side = side; Dd.gG = gG; Dd.gc = gc;
}
struct LazyEpi {
    static constexpr bool PERM = false, AFTER_DRAIN = false;
    KPtr p; int ph;
    __device__ __forceinline__ void operator()(const f32x4 (&acc)[2][2][4][2], const pg8::Unit& u, int wr, int wc, int fr, int fq) const {
        KPtr pp = p; int phh = ph; asm volatile("" : "+s"(pp), "+s"(phh));
        PhaseDesc Dd; pg8::Gemm g; pg8::Epi E; decode_phase(pp, phh, Dd, g, E);
        E(acc, u, wr, wc, fr, fq);
    }
};
__global__ void __launch_bounds__(NWAVES * 64, 2) fwd_kernel(Params pv) {
    KPtr p = (KPtr)__builtin_amdgcn_kernarg_segment_ptr();
    extern __shared__ __attribute__((aligned(16))) unsigned char lds_raw[];
    LAS unsigned char* lds = (LAS unsigned char*)lds_raw;
        const int ph_lo = p->ph_lo, ph_hi = p->ph_hi;
    volatile LAS unsigned* bst = (volatile LAS unsigned*)(lds + LDS_BYTES - 16);
    if (threadIdx.x == 0) { bst[0] = 0u; bst[1] = 0u; }
    __syncthreads();
    (void)xcd_barrier_post((unsigned*)(p->ws + WS_BAR), bst);
#ifndef PROBE_DUPS
#define PROBE_DUPS
#define PROBE_NDUP 0
#endif
    for (int pe = ph_lo; pe < ph_hi; ++pe) {
        int ph = pe; { const int dups_[] = {PROBE_DUPS -1}; for (int k_ = 0; k_ < PROBE_NDUP; ++k_) if (ph > dups_[k_]) --ph; }
        asm volatile("" : "+s"(p));
        int tid = threadIdx.x; asm volatile("" : "+v"(tid)); const int lane = tid & 63, wave = __builtin_amdgcn_readfirstlane(tid >> 6);
        PhaseDesc Dd; pg8::Gemm g; { pg8::Epi Eunused; decode_phase(p, ph, Dd, g, Eunused); }
        const int kind = Dd.kind, i = Dd.i; const bool side = Dd.side; const int gG = Dd.gG, gc = Dd.gc;
        if (kind == K_PREP) prep_phase(p, lds, wave, lane);
        else if (kind == K_GEMM) {
            if (side && blockIdx.x >= 64) side_phase(p, i, (blockIdx.x - 64) * NWAVES + wave, (gridDim.x - 64) * NWAVES, lds, wave, lane);
            else { pg8::StaticOrder S; S.init(g.M, g.N, gG, gc); LazyEpi LE{p, ph}; pg8::gemm_phase<LazyEpi, pg8::StaticOrder, true, true>(lds, g, S, LE); }
        }
        else if (kind == K_CMP2) cmp2_phase(p, i, wave, lane);
        else if (kind == K_ATTN) attn_phase(p, i, lds, wave, lane);
        else if (kind == K_SCANA) scan_phase<false>(p, i, lds, wave, lane);
        else scan_phase<true>(p, i, lds, wave, lane);
        if (pe + 1 < ph_hi) { asm volatile("s_waitcnt vmcnt(0) lgkmcnt(0)" ::: "memory"); if (ph_hi > 100000) cg::this_grid().sync();   { XcdBarrier gb_; gb_.bar = (unsigned*)(p->ws + WS_BAR); gb_.x = xb_xcc_id(); gb_.st = (volatile LAS unsigned*)(lds + LDS_BYTES - 16); xcd_barrier(gb_); } }
    }
}

#ifndef MK_PER_PHASE
#define MK_PER_PHASE 0
#endif
extern "C" void kernel_launch(void* const* d_in, const int* in_sizes, int n_in, void* d_out, int out_size, void* d_ws, size_t ws_size, hipStream_t stream) {
    static int grid = 0;
    if (grid == 0) {
        if (n_in != 25 || out_size != M * D || ws_size < WS_END) { fprintf(stderr, "kernel_launch: unexpected shapes (n_in %d out %d ws %zu)\n", n_in, out_size, ws_size); grid = -1; return; }
        if (hipFuncSetAttribute((const void*)fwd_kernel, hipFuncAttributeMaxDynamicSharedMemorySize, LDS_BYTES) != hipSuccess) { fprintf(stderr, "kernel_launch: hipFuncSetAttribute failed\n"); grid = -1; return; }
        int dev = 0, cus = 0, per_cu = 0;
        hipGetDevice(&dev); hipDeviceGetAttribute(&cus, hipDeviceAttributeMultiprocessorCount, dev);
        hipOccupancyMaxActiveBlocksPerMultiprocessor(&per_cu, (const void*)fwd_kernel, NWAVES * 64, LDS_BYTES);
        (void)hipGetLastError();
        if (per_cu < 1) { fprintf(stderr, "kernel_launch: occupancy query says %d blocks per CU\n", per_cu); per_cu = 1; }
        grid = cus;
        if (grid > 256) grid = 256;
    }
    if (grid < 0) return;
    if (hipMemsetAsync((char*)d_ws + WS_BAR, 0, 16384 + 16 * 256, stream) != hipSuccess) { fprintf(stderr, "kernel_launch: hipMemsetAsync failed\n"); return; }
    Params p{};
    for (int k = 0; k < 25; ++k) p.in[k] = (const float*)d_in[k];
    p.out = (float*)d_out; p.ws = (unsigned char*)d_ws;
#if MK_PER_PHASE
    for (int ph = 0; ph < NPHASES; ++ph) { p.ph_lo = ph; p.ph_hi = ph + 1; hipLaunchKernelGGL(fwd_kernel, dim3(grid), dim3(NWAVES * 64), LDS_BYTES, stream, p); }
#else
    p.ph_lo = 0; p.ph_hi = NPHASES + PROBE_NDUP;
    void* args[] = {&p};
    hipError_t e = hipLaunchCooperativeKernel((const void*)fwd_kernel, dim3(grid), dim3(NWAVES * 64), args, LDS_BYTES, stream);
    if (e != hipSuccess) fprintf(stderr, "cooperative launch failed: %s (grid %d)\n", hipGetErrorString(e), grid);
#endif
}
```
